# Optimizing an MI355X kernel written in HIP

```python
import jax, jax.numpy as jnp
from jax import lax
import numpy as np

D_MODEL = 1024
BATCH = 4
SEQ = 8192
DEPTH = 1

N_MEM = 256
D_MIX = D_MODEL
D_GLA = D_MIX // 2
GLA_HEADS = 4
GLA_DK = (D_GLA // 2) // GLA_HEADS
GLA_DV = D_GLA // GLA_HEADS
GLA_RANK = 16
GLA_NORMALIZER = 16.0
CHUNK = 64
D_POOL = D_MIX // 4
POOL_WINDOWS = (2, 4, 8, 16)
POOL_GROUP = D_POOL // len(POOL_WINDOWS)
D_MEM = D_MIX - D_GLA - D_POOL
MEM_HEADS = 4
MEM_DH = D_MEM // MEM_HEADS
EPS = 1e-6

SPLIT_SIZES = (
    GLA_HEADS * GLA_DK,
    GLA_HEADS * GLA_DK,
    D_GLA,
    GLA_RANK,
    D_GLA,
    D_POOL,
    D_POOL,
    D_MEM,
    D_MEM,
)
D_IN = int(sum(SPLIT_SIZES))
SPLIT_IDX = [int(i) for i in np.cumsum(SPLIT_SIZES)[:-1]]

kernel_name = "hybrid_gla_pool_memxattn_block"


def rmsnorm(x, g):
    x32 = x.astype(jnp.float32)
    y = x32 * lax.rsqrt(jnp.mean(x32 * x32, axis=-1, keepdims=True) + EPS)
    return (y * g.astype(jnp.float32)).astype(x.dtype)


def gla_chunked(q, k, v, gk):
    B, T, H, dk = q.shape
    dv = v.shape[-1]
    n = T // CHUNK

    def to_chunks(a):
        return a.astype(jnp.float32).reshape(B, n, CHUNK, H, a.shape[-1]).transpose(0, 3, 1, 2, 4)

    q, k, v, gk = to_chunks(q) * (dk ** -0.5), to_chunks(k), to_chunks(v), to_chunks(gk)
    b = jnp.cumsum(gk, axis=3)
    q_d = q * jnp.exp(b)
    k_d = k * jnp.exp(-b)
    scores = jnp.einsum('bhnid,bhnjd->bhnij', q_d, k_d)
    tril = jnp.tril(jnp.ones((CHUNK, CHUNK), dtype=bool))
    scores = jnp.where(tril, scores, 0.0)
    o_intra = jnp.einsum('bhnij,bhnje->bhnie', scores, v)
    b_last = b[:, :, :, -1:, :]
    k_end = k * jnp.exp(b_last - b)
    chunk_state = jnp.einsum('bhncd,bhnce->bhnde', k_end, v)
    chunk_decay = jnp.exp(b_last[:, :, :, 0, :])

    def step(S, inp):
        dec, cs = inp
        return dec[..., None] * S + cs, S

    S0 = jnp.zeros((B, H, dk, dv), jnp.float32)
    _, S_prev = lax.scan(step, S0, (jnp.moveaxis(chunk_decay, 2, 0), jnp.moveaxis(chunk_state, 2, 0)))
    S_prev = jnp.moveaxis(S_prev, 0, 2)
    o_inter = jnp.einsum('bhncd,bhnde->bhnce', q_d, S_prev)
    o = o_intra + o_inter
    return o.transpose(0, 2, 3, 1, 4).reshape(B, T, H, dv)


def multiscale_pool(u):
    B, T, _ = u.shape
    u32 = u.astype(jnp.float32)
    cs = jnp.cumsum(u32, axis=1)
    W = max(POOL_WINDOWS)
    cs_pad = jnp.concatenate([jnp.zeros((B, W, D_POOL), jnp.float32), cs], axis=1)
    pos = jnp.arange(T)
    outs = []
    for g, w in enumerate(POOL_WINDOWS):
        lo, hi = g * POOL_GROUP, (g + 1) * POOL_GROUP
        c_now = cs[:, :, lo:hi]
        c_prev = cs_pad[:, W - w:W - w + T, lo:hi]
        count = jnp.minimum(pos + 1, w).astype(jnp.float32)[None, :, None]
        outs.append((c_now - c_prev) / count - u32[:, :, lo:hi])
    return jnp.stack(outs, axis=2)


def memory_attention(q_mem, mem_n, w_mem_kv):
    B, T, _ = q_mem.shape
    M = mem_n.shape[1]
    kv = mem_n @ w_mem_kv
    k_m, v_m = jnp.split(kv, 2, axis=-1)
    q = q_mem.reshape(B, T, MEM_HEADS, MEM_DH)
    k_m = k_m.reshape(B, M, MEM_HEADS, MEM_DH)
    v_m = v_m.reshape(B, M, MEM_HEADS, MEM_DH)
    s = jnp.einsum('bthd,bmhd->bhtm', q.astype(jnp.float32), k_m.astype(jnp.float32)) * (MEM_DH ** -0.5)
    p = jax.nn.softmax(s, axis=-1)
    o = jnp.einsum('bhtm,bmhd->bthd', p, v_m.astype(jnp.float32))
    return o.reshape(B, T, D_MEM)


def setup_inputs(seed: int = 0) -> dict:
    key = jax.random.key(seed)
    ks = jax.random.split(key, 14)
    f = jnp.float32
    return {
        "x": jax.random.normal(ks[0], (BATCH, SEQ, D_MODEL), f),
        "mem": jax.random.normal(ks[1], (BATCH, N_MEM, D_MODEL), f),
        "norm_g": 1.0 + 0.02 * jax.random.normal(ks[2], (D_MODEL,), f),
        "w_in": jax.random.normal(ks[3], (D_MODEL, D_IN), f) * D_MODEL ** -0.5,
        "w_gk_up": jax.random.normal(ks[4], (GLA_RANK, GLA_HEADS * GLA_DK), f) * GLA_RANK ** -0.5,
        "b_gk": 0.01 * jax.random.normal(ks[5], (GLA_HEADS * GLA_DK,), f),
        "gla_norm_g": 1.0 + 0.02 * jax.random.normal(ks[6], (GLA_DV,), f),
        "pool_w": jax.random.normal(ks[7], (len(POOL_WINDOWS), POOL_GROUP, POOL_GROUP), f) * POOL_GROUP ** -0.5,
        "pool_scale": 1.0 + 0.02 * jax.random.normal(ks[8], (D_POOL,), f),
        "mem_norm_g": 1.0 + 0.02 * jax.random.normal(ks[9], (D_MODEL,), f),
        "w_mem_kv": jax.random.normal(ks[10], (D_MODEL, 2 * D_MEM), f) * D_MODEL ** -0.5,
        "w_out": jax.random.normal(ks[11], (D_MIX, D_MODEL), f) * D_MIX ** -0.5,
        "final_g": 1.0 + 0.02 * jax.random.normal(ks[12], (D_MODEL,), f),
    }


def reference(x, mem, norm_g, w_in, w_gk_up, b_gk, gla_norm_g, pool_w, pool_scale,
              mem_norm_g, w_mem_kv, w_out, final_g):
    B, T, _ = x.shape
    dt = x.dtype
    mem_n = rmsnorm(mem, mem_norm_g)
    for _layer in range(DEPTH):
        h = rmsnorm(x, norm_g)
        proj = h @ w_in
        q_g, k_g, v_g, gk_lr, gate_g, u_p, gate_p, q_m, gate_m = jnp.split(proj, SPLIT_IDX, axis=-1)

        gk_logit = (gk_lr @ w_gk_up + b_gk).astype(jnp.float32)
        gk = jax.nn.log_sigmoid(gk_logit) / GLA_NORMALIZER
        o_gla = gla_chunked(q_g.reshape(B, T, GLA_HEADS, GLA_DK),
                            k_g.reshape(B, T, GLA_HEADS, GLA_DK),
                            v_g.reshape(B, T, GLA_HEADS, GLA_DV),
                            gk.reshape(B, T, GLA_HEADS, GLA_DK))
        o_gla = rmsnorm(o_gla, gla_norm_g).reshape(B, T, D_GLA)
        o_gla = (o_gla * jax.nn.silu(gate_g.astype(jnp.float32))).astype(dt)

        pooled = multiscale_pool(u_p)
        o_pool = jnp.einsum('btgp,gpq->btgq', pooled, pool_w.astype(jnp.float32)).reshape(B, T, D_POOL)
        o_pool = (o_pool * pool_scale.astype(jnp.float32) * jax.nn.silu(gate_p.astype(jnp.float32))).astype(dt)

        o_mem = memory_attention(q_m, mem_n, w_mem_kv)
        o_mem = (o_mem * jax.nn.silu(gate_m.astype(jnp.float32))).astype(dt)

        mixed = jnp.concatenate([o_gla, o_pool, o_mem], axis=-1)
        x = x + mixed @ w_out
    return rmsnorm(x, final_g)
```

```cpp
#include <hip/hip_runtime.h>
#include <cstdio>

#define DI __device__ __forceinline__
#define LAS __attribute__((address_space(3)))
typedef unsigned short u16;
typedef short bf16x8 __attribute__((ext_vector_type(8)));
typedef float f32x4 __attribute__((ext_vector_type(4)));
typedef float f32x2 __attribute__((ext_vector_type(2)));
typedef float f32x16 __attribute__((ext_vector_type(16)));
typedef unsigned u32x4 __attribute__((ext_vector_type(4)));
typedef unsigned u32x2 __attribute__((ext_vector_type(2)));
typedef __bf16 bfv2 __attribute__((ext_vector_type(2)));
typedef _Float16 h16x8 __attribute__((ext_vector_type(8)));
typedef float f32x8 __attribute__((ext_vector_type(8)));

constexpr int NTOK = 32768, DM = 1024, DIN = 2576, NMAIN = 2560, SEQ = 8192;
constexpr int C_Q = 0, C_K = 256, C_V = 512, C_GG = 1024, C_UP = 1536, C_GP = 1792, C_QM = 2048, C_GM = 2304;
constexpr size_t PB_Q = (size_t)NTOK * C_Q, PB_K = (size_t)NTOK * C_K, PB_V = (size_t)NTOK * C_V, PB_GG = (size_t)NTOK * C_GG, PB_UP = (size_t)NTOK * C_UP, PB_GP = (size_t)NTOK * C_GP, PB_QM = (size_t)NTOK * C_QM, PB_GM = (size_t)NTOK * C_GM;
constexpr float EPS = 1e-6f;

struct Ctx {
    const float *x, *mem, *norm_g, *w_in, *w_gk_up, *b_gk, *gla_norm_g, *pool_w, *pool_scale, *mem_norm_g, *w_mem_kv, *w_out, *final_g;
    float* out;
    u16 *WiT, *WoT, *Hb, *kv, *proj, *cs, *mixed;
    float *rs, *gklr, *dec;
    u16* bcum;
    unsigned* bar; float* slots;
};

DI float bf2f(u16 b) { return __uint_as_float((unsigned)b << 16); }
DI unsigned pk2(float a, float b) { f32x2 v = {a, b}; bfv2 r = __builtin_convertvector(v, bfv2); return __builtin_bit_cast(unsigned, r); }
DI u16 f2bf(float a) { return (u16)(pk2(a, 0.f) & 0xffffu); }
DI float lo16(unsigned w) { return __uint_as_float(w << 16); }
DI float hi16(unsigned w) { return __uint_as_float(w & 0xffff0000u); }
DI float silu(float v) { return v / (1.f + __expf(-v)); }
DI int crow(int reg, int h) { return (reg & 3) + 8 * (reg >> 2) + 4 * h; }
DI f32x16 mfma32(bf16x8 a, bf16x8 b, f32x16 c) { return __builtin_amdgcn_mfma_f32_32x32x16_bf16(a, b, c, 0, 0, 0); }
DI f32x4 mfma16(bf16x8 a, bf16x8 b, f32x4 c) { return __builtin_amdgcn_mfma_f32_16x16x32_bf16(a, b, c, 0, 0, 0); }
DI f32x16 zero16() { f32x16 z; for (int i = 0; i < 16; ++i) z[i] = 0.f; return z; }
DI float shx(float v, int m) { return __shfl_xor(v, m); }
typedef short v4i16_t __attribute__((ext_vector_type(4)));
DI void swap32(unsigned& a, unsigned& b) { const auto r = __builtin_amdgcn_permlane32_swap(a, b, false, false); a = r[0]; b = r[1]; }
DI v4i16_t vtr(const LAS u16* p) { return __builtin_amdgcn_ds_read_tr16_b64_v4i16((LAS v4i16_t*)p); }
DI bf16x8 tr_frag(const LAS u16* img, int stride, int row_lo, int row_hi, int col0, int lane) {
    const int i16 = lane & 15, blk = (lane >> 4) & 1, q = i16 >> 2, p = i16 & 3;
    const v4i16_t lo = vtr(img + (row_lo + q) * stride + col0 + blk * 16 + 4 * p), hi = vtr(img + (row_hi + q) * stride + col0 + blk * 16 + 4 * p);
    return __builtin_shufflevector(lo, hi, 0, 1, 2, 3, 4, 5, 6, 7);
}

namespace pg8 {
constexpr int BM = 256, BK = 64, HALF = 128, HTB = HALF * BK * 2, STAGE_BYTES = 8 * HTB, NXCD = 8, WGM = 8;
DI int lds_byte(int r, int c) { const int st = (r >> 4) * 2 + (c >> 5), rr = r & 15, cc = c & 31, ob = rr * 64 + cc * 2; return st * 1024 + (ob ^ (((ob >> 9) & 1) << 5)); }
DI void stage_rc(int b, int& R, int& C) { const int st = b / 1024, sb = b % 1024, swz = sb ^ (((sb >> 9) & 1) << 5); R = (st >> 1) * 16 + swz / 64; C = (st & 1) * 32 + (swz % 64) / 2; }
DI int perm32(int rho) { const int n = rho >> 4, i = rho & 15; return 8 * (i >> 2) + 4 * n + (i & 3); }
struct Unit { int pm, pn; };
struct Gemm { const u16* A; const u16* Bt; int M, N, K; };
struct StaticOrder {
    int nM, nN, nwg, G, c;
    DI void init(int M, int N, int G_, int c_) { nM = M / BM; nN = N / BM; nwg = nM * nN; G = G_; c = c_; }
    DI bool next(int i, Unit& u) const {
        const long L = (long)i * G + c; if (L >= nwg) return false;
        int wgid = (int)L; { const int q = nwg / NXCD, r = nwg % NXCD, xcd = wgid % NXCD, off = wgid / NXCD; wgid = (xcd < r ? xcd * (q + 1) : r * (q + 1) + (xcd - r) * q) + off; }
        const int nig = WGM * nN, gid = wgid / nig, fm = gid * WGM, gsz = (nM - fm) < WGM ? (nM - fm) : WGM;
        u.pm = fm + ((wgid % nig) % gsz); u.pn = (wgid % nig) / gsz; return true;
    }
};

template <class Epi>
DI void gemm_phase(LAS unsigned char* lds, const Gemm g, const StaticOrder& S, const Epi& E) {
    int tid_l = threadIdx.x; asm volatile("" : "+v"(tid_l)); const int tid = tid_l, wid = __builtin_amdgcn_readfirstlane(tid >> 6), lane = tid & 63, wr = wid >> 2, wc = wid & 3, fr = lane & 15, fq = lane >> 4;
    const int K = g.K, nt = K / BK;
    unsigned voffA[2], voffB[2];
#pragma unroll
    for (int i = 0; i < 2; ++i) { int R, C; stage_rc(tid * 16 + i * 8192, R, C); const int Rb = Epi::PERM ? ((R & ~31) + perm32(R & 31)) : R;
        voffA[i] = (unsigned)(R * K + C) * 2u; voffB[i] = (unsigned)(Rb * K + C) * 2u; }
    const size_t kstep = (size_t)(BK * 2);
    const size_t hstep = (size_t)HALF * K * 2;
    const size_t tstep = 2 * hstep;
    const unsigned ldsw = (unsigned)wid * 1024u;
    const int aoff = lds_byte(wr * 64 + fr, fq * 8), boff = lds_byte(wc * 32 + fr, fq * 8);
#define PG8_SA(b, h) (((b) * 2 + (h)) * HTB)
#define PG8_SB(b, h) ((4 + (b) * 2 + (h)) * HTB)
#define PG8_STAGE(bufoff, gbase, voff) do { _Pragma("unroll") for (int _i = 0; _i < 2; ++_i) \
        __builtin_amdgcn_global_load_lds((const unsigned*)((const char*)(gbase) + (voff)[_i]), (LAS unsigned*)(lds + (bufoff) + ldsw + _i * 8192), 16, 0, 0); } while (0)
#define PG8_LDA(dst, b, h) do { _Pragma("unroll") for (int m = 0; m < 4; ++m) _Pragma("unroll") for (int k = 0; k < 2; ++k) dst[m][k] = *(const LAS bf16x8*)(lds + PG8_SA(b, h) + aoff + m * 2048 + k * 1024); } while (0)
#define PG8_LDB(dst, b, h) do { _Pragma("unroll") for (int n = 0; n < 2; ++n) _Pragma("unroll") for (int k = 0; k < 2; ++k) dst[n][k] = *(const LAS bf16x8*)(lds + PG8_SB(b, h) + boff + n * 2048 + k * 1024); } while (0)
#define PG8_MMA(ai, bj, At, Bt) do { __builtin_amdgcn_s_setprio(1); _Pragma("unroll") for (int m = 0; m < 4; ++m) _Pragma("unroll") for (int n = 0; n < 2; ++n) _Pragma("unroll") for (int k = 0; k < 2; ++k) \
        acc[ai][bj][m][n] = __builtin_amdgcn_mfma_f32_16x16x32_bf16(Bt[n][k], At[m][k], acc[ai][bj][m][n], 0, 0, 0); __builtin_amdgcn_s_setprio(0); } while (0)
#define PG8_WAIT_V(n) asm volatile("s_waitcnt vmcnt(" #n ")" ::: "memory")
#define PG8_WAIT_L(n) asm volatile("s_waitcnt lgkmcnt(" #n ")" ::: "memory")
#define PG8_BAR __builtin_amdgcn_s_barrier()
#define PG8_SCHED __builtin_amdgcn_sched_barrier(0)
    Unit cur, nxt; int ui = 0;
    if (!S.next(0, cur)) return;
    f32x4 acc[2][2][4][2];
#pragma unroll
    for (int a = 0; a < 2; ++a)
#pragma unroll
        for (int b = 0; b < 2; ++b)
#pragma unroll
            for (int m = 0; m < 4; ++m)
#pragma unroll
                for (int n = 0; n < 2; ++n) acc[a][b][m][n] = (f32x4){0.f, 0.f, 0.f, 0.f};
    bf16x8 At[4][2], B0[2][2], B1[2][2];
    const char* cA = (const char*)g.A + (size_t)cur.pm * tstep; const char* cB = (const char*)g.Bt + (size_t)cur.pn * tstep;
    float pre[8];
    if constexpr (Epi::PRELOAD) E.preload(cur, wr, fr, pre);
    PG8_STAGE(PG8_SB(0, 0), cB, voffB); PG8_STAGE(PG8_SA(0, 0), cA, voffA); PG8_STAGE(PG8_SB(0, 1), cB + hstep, voffB); PG8_STAGE(PG8_SA(0, 1), cA + hstep, voffA);
    if (wr == 1) PG8_BAR;
    PG8_WAIT_V(4); PG8_BAR;
    PG8_STAGE(PG8_SB(1, 0), cB + kstep, voffB); PG8_STAGE(PG8_SA(1, 0), cA + kstep, voffA); PG8_STAGE(PG8_SB(1, 1), cB + hstep + kstep, voffB);
    PG8_WAIT_V(6); PG8_BAR;
    for (;;) {
        const bool has_next = S.next(ui + 1, nxt);
        const char* nA = has_next ? (const char*)g.A + (size_t)nxt.pm * tstep : cA; const char* nB = has_next ? (const char*)g.Bt + (size_t)nxt.pn * tstep : cB;
        for (int t = 0; t < nt; t += 2) {
            const bool last = (t == nt - 2);
            const char* a1 = cA + (size_t)(t + 1) * kstep;
            const char* a2 = last ? nA : cA + (size_t)(t + 2) * kstep; const char* b2 = last ? nB : cB + (size_t)(t + 2) * kstep;
            const char* a3 = a2 + kstep; const char* b3 = b2 + kstep;
            PG8_LDB(B0, 0, 0); PG8_SCHED; PG8_LDA(At, 0, 0); PG8_STAGE(PG8_SA(1, 1), a1 + hstep, voffA);
            PG8_WAIT_L(8); PG8_BAR; PG8_WAIT_L(0); PG8_MMA(0, 0, At, B0); PG8_BAR; PG8_SCHED;
            PG8_LDB(B1, 0, 1); PG8_STAGE(PG8_SB(0, 0), b2, voffB);
            PG8_BAR; PG8_WAIT_L(0); PG8_MMA(0, 1, At, B1); PG8_BAR;
            PG8_LDA(At, 0, 1); PG8_STAGE(PG8_SA(0, 0), a2, voffA);
            PG8_BAR; PG8_WAIT_L(0); PG8_MMA(1, 0, At, B0); PG8_BAR; PG8_SCHED;
            PG8_STAGE(PG8_SB(0, 1), b2 + hstep, voffB);
            PG8_WAIT_V(6); PG8_BAR; PG8_MMA(1, 1, At, B1); PG8_BAR;
            PG8_LDB(B0, 1, 0); PG8_SCHED; PG8_LDA(At, 1, 0); PG8_STAGE(PG8_SA(0, 1), a2 + hstep, voffA);
            PG8_WAIT_L(8); PG8_BAR; PG8_WAIT_L(0); PG8_MMA(0, 0, At, B0); PG8_BAR; PG8_SCHED;
            PG8_LDB(B1, 1, 1); PG8_STAGE(PG8_SB(1, 0), b3, voffB);
            PG8_BAR; PG8_WAIT_L(0); PG8_MMA(0, 1, At, B1); PG8_BAR;
            PG8_LDA(At, 1, 1); PG8_STAGE(PG8_SA(1, 0), a3, voffA);
            PG8_BAR; PG8_WAIT_L(0); PG8_MMA(1, 0, At, B0); PG8_BAR; PG8_SCHED;
            PG8_STAGE(PG8_SB(1, 1), b3 + hstep, voffB);
            PG8_WAIT_V(6); PG8_BAR; PG8_MMA(1, 1, At, B1); PG8_BAR;
        }
        if constexpr (!Epi::AFTER_DRAIN) E(acc, cur, wr, wc, fr, fq, pre);
        if (!has_next) break;
#pragma unroll
        for (int a = 0; a < 2; ++a)
#pragma unroll
            for (int b = 0; b < 2; ++b)
#pragma unroll
                for (int m = 0; m < 4; ++m)
#pragma unroll
                    for (int n = 0; n < 2; ++n) acc[a][b][m][n] = (f32x4){0.f, 0.f, 0.f, 0.f};
        cur = nxt; cA = nA; cB = nB; ++ui;
        if constexpr (Epi::PRELOAD) E.preload(cur, wr, fr, pre);
    }
    u32x4 xpre[16];
    if constexpr (Epi::AFTER_DRAIN) E.prefetch(cur, wr, wc, fr, fq, xpre);
    PG8_WAIT_V(0);
    if (wr == 0) PG8_BAR;
    PG8_BAR;
    if constexpr (Epi::AFTER_DRAIN) E.fused(acc, cur, wr, wc, fr, fq, lds, xpre);
#undef PG8_SA
#undef PG8_SB
#undef PG8_STAGE
#undef PG8_LDA
#undef PG8_LDB
#undef PG8_MMA
#undef PG8_WAIT_V
#undef PG8_WAIT_L
#undef PG8_BAR
#undef PG8_SCHED
}
}

struct EpiProj {
    static constexpr bool PERM = true, AFTER_DRAIN = false, PRELOAD = true;
    u16* O; const float* rs;
    DI void preload(const pg8::Unit& u, int wr, int fr, float (&pre)[8]) const {
        const int row0 = u.pm * 256 + wr * 64 + fr;
#pragma unroll
        for (int ai = 0; ai < 2; ++ai)
#pragma unroll
            for (int m = 0; m < 4; ++m) pre[ai * 4 + m] = rs[row0 + ai * 128 + m * 16];
    }
    DI void operator()(const f32x4 (&acc)[2][2][4][2], const pg8::Unit& u, int wr, int wc, int fr, int fq, const float (&pre)[8]) const {
        const int gc = (u.pn == 3) ? 512 : (u.pn == 5) ? 1024 : u.pn * 256, gw = (u.pn >= 2 && u.pn <= 5) ? 512 : 256;
        const size_t gbase = (size_t)NTOK * gc;
        const int row0 = u.pm * 256 + wr * 64 + fr, col0 = u.pn * 256 - gc + wc * 32 + 8 * fq;
#pragma unroll
        for (int ai = 0; ai < 2; ++ai)
#pragma unroll
            for (int m = 0; m < 4; ++m) { const int row = row0 + ai * 128 + m * 16; const float s = pre[ai * 4 + m]; u16* rowp = O + gbase + (size_t)row * gw + col0;
#pragma unroll
                for (int bj = 0; bj < 2; ++bj) { const f32x4 v0 = acc[ai][bj][m][0] * s, v1 = acc[ai][bj][m][1] * s;
                    u32x4 w; w.x = pk2(v0[0], v0[1]); w.y = pk2(v0[2], v0[3]); w.z = pk2(v1[0], v1[1]); w.w = pk2(v1[2], v1[3]);
                    *(u32x4*)(rowp + bj * 128) = w; } }
    }
};
struct EpiOutNorm {
    static constexpr bool PERM = true, AFTER_DRAIN = true, PRELOAD = false;
    const u16* xb; float* out; const float* g; float* slots; unsigned* cnt; unsigned* tmo; int rowbase, panelbase;
    DI void operator()(const f32x4 (&)[2][2][4][2], const pg8::Unit&, int, int, int, int, const float (&)[8]) const {}
    DI void prefetch(const pg8::Unit& u, int wr, int wc, int fr, int fq, u32x4 (&xpre)[16]) const {
        const u16* xr = xb + ((size_t)rowbase + (size_t)u.pm * 256 + wr * 64 + fr) * DM + u.pn * 256 + wc * 32 + 8 * fq;
#pragma unroll
        for (int ai = 0; ai < 2; ++ai)
#pragma unroll
            for (int m = 0; m < 4; ++m) { xpre[(ai * 4 + m) * 2] = *(const u32x4*)(xr + (size_t)(ai * 128 + m * 16) * DM); xpre[(ai * 4 + m) * 2 + 1] = *(const u32x4*)(xr + (size_t)(ai * 128 + m * 16) * DM + 128); }
    }
    DI void fused(f32x4 (&acc)[2][2][4][2], const pg8::Unit& u, int wr, int wc, int fr, int fq, LAS unsigned char* lds, const u32x4 (&xpre)[16]) const {
        int tid_l = threadIdx.x; asm volatile("" : "+v"(tid_l)); const int tid = tid_l;
        LAS float* P = (LAS float*)lds;
        LAS float* R = (LAS float*)(lds + 4096);
        const int trow0 = wr * 64 + fr, col0 = u.pn * 256 + wc * 32 + 8 * fq, pmg = panelbase + u.pm;
        const size_t grow0 = (size_t)rowbase + (size_t)u.pm * 256;
#pragma unroll
        for (int ai = 0; ai < 2; ++ai)
#pragma unroll
            for (int m = 0; m < 4; ++m) { const int trow = trow0 + ai * 128 + m * 16; const u16* xr = xb + (grow0 + trow) * DM + col0; float ss = 0.f;
#pragma unroll
                for (int bj = 0; bj < 2; ++bj) { const u32x4 xv = xpre[(ai * 4 + m) * 2 + bj];
                    f32x4 v0 = acc[ai][bj][m][0], v1 = acc[ai][bj][m][1];
                    v0[0] += lo16(xv.x); v0[1] += hi16(xv.x); v0[2] += lo16(xv.y); v0[3] += hi16(xv.y); v1[0] += lo16(xv.z); v1[1] += hi16(xv.z); v1[2] += lo16(xv.w); v1[3] += hi16(xv.w);
                    acc[ai][bj][m][0] = v0; acc[ai][bj][m][1] = v1;
                    ss += v0[0] * v0[0] + v0[1] * v0[1] + v0[2] * v0[2] + v0[3] * v0[3] + v1[0] * v1[0] + v1[1] * v1[1] + v1[2] * v1[2] + v1[3] * v1[3]; }
                ss += shx(ss, 16); ss += shx(ss, 32);
                if (fq == 0) P[trow * 4 + wc] = ss; }
        __syncthreads();
        if (tid < 256) {
            const f32x4 p4 = *(const LAS f32x4*)(P + tid * 4);
            __hip_atomic_store(slots + (size_t)(pmg * 4 + u.pn) * 256 + tid, p4[0] + p4[1] + p4[2] + p4[3], __ATOMIC_RELAXED, __HIP_MEMORY_SCOPE_AGENT);
            asm volatile("s_waitcnt vmcnt(0)" ::: "memory");
            if ((tid & 63) == 0) __hip_atomic_fetch_add(cnt + pmg * 64, 1u, __ATOMIC_RELAXED, __HIP_MEMORY_SCOPE_AGENT);
        }
        if (tid < 64) {
            if (tid == 0) { unsigned sp = 0;
                while (__hip_atomic_load(cnt + pmg * 64, __ATOMIC_RELAXED, __HIP_MEMORY_SCOPE_AGENT) < 16u) { __builtin_amdgcn_s_sleep(1);
                    if ((++sp & 255u) == 0u) { if (__hip_atomic_load(tmo, __ATOMIC_RELAXED, __HIP_MEMORY_SCOPE_AGENT)) break; if (sp > (1u << 20)) { atomicAdd(tmo, 1u); break; } } } }
            __builtin_amdgcn_fence(__ATOMIC_ACQUIRE, "agent");
            asm volatile("s_waitcnt vmcnt(0)" ::: "memory");
        }
        __syncthreads();
        if (tid < 256) { float tot = 0.f;
#pragma unroll
            for (int j = 0; j < 4; ++j) tot += __hip_atomic_load(slots + (size_t)(pmg * 4 + j) * 256 + tid, __ATOMIC_RELAXED, __HIP_MEMORY_SCOPE_AGENT);
            R[tid] = rsqrtf(tot * (1.f / 1024.f) + EPS); }
        __syncthreads();
        f32x4 gv[2][2];
#pragma unroll
        for (int bj = 0; bj < 2; ++bj)
#pragma unroll
            for (int n = 0; n < 2; ++n) gv[bj][n] = *(const f32x4*)(g + col0 + bj * 128 + n * 4);
#pragma unroll
        for (int ai = 0; ai < 2; ++ai)
#pragma unroll
            for (int m = 0; m < 4; ++m) { const int trow = trow0 + ai * 128 + m * 16; const float rn = R[trow]; float* orow = out + (grow0 + trow) * DM + col0;
#pragma unroll
                for (int bj = 0; bj < 2; ++bj)
#pragma unroll
                    for (int n = 0; n < 2; ++n) *(f32x4*)(orow + bj * 128 + n * 4) = acc[ai][bj][m][n] * rn * gv[bj][n]; }
        __syncthreads();
    }
};

DI void phase_prep(const Ctx& c, LAS unsigned char* lds, int part) {
    int tid_l = threadIdx.x; asm volatile("" : "+v"(tid_l)); const int tid = tid_l, wave = tid >> 6, lane = tid & 63, fr = lane & 15, fq = lane >> 4;
    LAS u16* WgT = (LAS u16*)lds;
    LAS u16* tl = (LAS u16*)(lds + 40960);
    if (part == 0) {
    for (int i = tid; i < 16384; i += 512) { const int k = i >> 4, n = i & 15; WgT[n * 1032 + k] = f2bf(c.w_in[(size_t)k * DIN + 1024 + n] * c.norm_g[k]); }
    __syncthreads();
    for (int grp = blockIdx.x * 8 + wave; grp < NTOK / 16; grp += gridDim.x * 8) {
        const int row0 = grp * 16;
        const float* xr = c.x + (size_t)(row0 + fr) * DM + fq * 8; u16* hr = c.Hb + (size_t)(row0 + fr) * DM + fq * 8;
        f32x4 acc = {0.f, 0.f, 0.f, 0.f}; float ss = 0.f;
#pragma unroll 4
        for (int st = 0; st < 32; ++st) {
            const f32x4 x0 = __builtin_nontemporal_load((const f32x4*)(xr + st * 32)), x1 = __builtin_nontemporal_load((const f32x4*)(xr + st * 32 + 4));
            ss += x0[0] * x0[0] + x0[1] * x0[1] + x0[2] * x0[2] + x0[3] * x0[3] + x1[0] * x1[0] + x1[1] * x1[1] + x1[2] * x1[2] + x1[3] * x1[3];
            u32x4 w; w.x = pk2(x0[0], x0[1]); w.y = pk2(x0[2], x0[3]); w.z = pk2(x1[0], x1[1]); w.w = pk2(x1[2], x1[3]);
            *(u32x4*)(hr + st * 32) = w;
            const bf16x8 bfr = *(const LAS bf16x8*)(WgT + fr * 1032 + st * 32 + fq * 8);
            acc = mfma16(__builtin_bit_cast(bf16x8, w), bfr, acc);
        }
        ss += shx(ss, 16); ss += shx(ss, 32);
        const float rsv = rsqrtf(ss * (1.f / 1024.f) + EPS);
        if (fq == 0) c.rs[row0 + fr] = rsv;
#pragma unroll
        for (int j = 0; j < 4; ++j) { const float rsj = __shfl(rsv, 4 * fq + j); c.gklr[(size_t)(row0 + 4 * fq + j) * 16 + fr] = acc[j] * rsj; }
    }
    }
    if (part == 1)
    for (int tile = blockIdx.x; tile < 256; tile += gridDim.x) {
        const int row0 = (tile >> 4) * 64 + (wave & 3) * 16, col0 = (tile & 15) * 32 + (wave >> 2) * 16;
        const float* mr = c.mem + (size_t)(row0 + fr) * DM + fq * 8;
        f32x4 acc = {0.f, 0.f, 0.f, 0.f}; float ss = 0.f;
#pragma unroll 8
        for (int st = 0; st < 32; ++st) {
            const f32x4 x0 = *(const f32x4*)(mr + st * 32), x1 = *(const f32x4*)(mr + st * 32 + 4);
            const f32x4 g0 = *(const f32x4*)(c.mem_norm_g + st * 32 + fq * 8), g1 = *(const f32x4*)(c.mem_norm_g + st * 32 + fq * 8 + 4);
            ss += x0[0] * x0[0] + x0[1] * x0[1] + x0[2] * x0[2] + x0[3] * x0[3] + x1[0] * x1[0] + x1[1] * x1[1] + x1[2] * x1[2] + x1[3] * x1[3];
            u32x4 w; w.x = pk2(x0[0] * g0[0], x0[1] * g0[1]); w.y = pk2(x0[2] * g0[2], x0[3] * g0[3]); w.z = pk2(x1[0] * g1[0], x1[1] * g1[1]); w.w = pk2(x1[2] * g1[2], x1[3] * g1[3]);
            const float* wp = c.w_mem_kv + (size_t)(st * 32 + fq * 8) * 512 + col0 + fr;
            u32x4 bw; bw.x = pk2(wp[0], wp[512]); bw.y = pk2(wp[1024], wp[1536]); bw.z = pk2(wp[2048], wp[2560]); bw.w = pk2(wp[3072], wp[3584]);
            acc = mfma16(__builtin_bit_cast(bf16x8, w), __builtin_bit_cast(bf16x8, bw), acc);
        }
        ss += shx(ss, 16); ss += shx(ss, 32);
        const float rsv = rsqrtf(ss * (1.f / 1024.f) + EPS);
#pragma unroll
        for (int j = 0; j < 4; ++j) { const float rsj = __shfl(rsv, 4 * fq + j); c.kv[(size_t)(row0 + 4 * fq + j) * 512 + col0 + fr] = f2bf(acc[j] * rsj); }
    }
    if (part != 1)
    for (int tile = (part == 0 ? 0 : 640) + blockIdx.x; tile < (part == 0 ? 640 : 896); tile += gridDim.x) {
        const float* src; int ld; u16* dst;
        if (tile < 640) { const int kt = tile / 40, ntl = tile % 40, n0 = ntl * 64, sc = n0 < 1024 ? n0 : n0 + 16; src = c.w_in + (size_t)(kt * 64) * DIN + sc; ld = DIN; dst = c.WiT + (size_t)n0 * 1024 + kt * 64; }
        else { const int t2 = tile - 640, kt = t2 >> 4, ntl = t2 & 15; src = c.w_out + (size_t)(kt * 64) * 1024 + ntl * 64; ld = 1024; dst = c.WoT + (size_t)(ntl * 64) * 1024 + kt * 64; }
#pragma unroll
        for (int i = 0; i < 2; ++i) { const int kk = (tid >> 4) + 32 * i, nn = (tid & 15) * 4; const float gk = tile < 640 ? c.norm_g[(tile / 40) * 64 + kk] : 1.f; const f32x4 v = *(const f32x4*)(src + (size_t)kk * ld + nn) * gk;
            tl[(nn + 0) * 72 + kk] = f2bf(v[0]); tl[(nn + 1) * 72 + kk] = f2bf(v[1]); tl[(nn + 2) * 72 + kk] = f2bf(v[2]); tl[(nn + 3) * 72 + kk] = f2bf(v[3]); }
        __syncthreads();
        { const int n = tid >> 3, kc = (tid & 7) * 8; *(u32x4*)(dst + (size_t)n * 1024 + kc) = *(const LAS u32x4*)(tl + n * 72 + kc); }
        __syncthreads();
    }
}

constexpr int VS_STRIDE = 528, VS_BYTES = 64 * VS_STRIDE * 2;
DI void phase_gla_cs(const Ctx& c, LAS unsigned char* lds) {
    int tid_l = threadIdx.x; asm volatile("" : "+v"(tid_l)); const int tid = tid_l, wave = tid >> 6, lane = tid & 63, hs = lane >> 5, r = lane & 31;
    LAS u16* Vs = (LAS u16*)lds;
    LAS u16* Kk = (LAS u16*)(lds + VS_BYTES);
    LAS u16* kdT = (LAS u16*)(lds + VS_BYTES + 32768);
    LAS float* decS = (LAS float*)(lds + VS_BYTES + 32768 + 36864);
    LAS float* totS = decS + 256;
    u32x4 pre[12];
    int item = blockIdx.x;
    if (item < 512) {
        const int tok0 = (item >> 7) * SEQ + (item & 127) * 64;
#pragma unroll
        for (int i = 0; i < 8; ++i) { const int id = tid + 512 * i; pre[i] = *(const u32x4*)(c.proj + PB_V + (size_t)(tok0 + (id >> 6)) * 512 + (id & 63) * 8); }
#pragma unroll
        for (int i = 0; i < 4; ++i) { const int id = tid + 512 * i; pre[8 + i] = *(const u32x4*)(c.proj + PB_K + (size_t)(tok0 + (id >> 5)) * 256 + (id & 31) * 8); }
    }
    for (; item < 512; item += gridDim.x) {
        const int b = item >> 7, n = item & 127, tok0 = b * SEQ + n * 64;
        const int h = wave >> 1, half = wave & 1, d = lane;
#pragma unroll
        for (int i = 0; i < 8; ++i) { const int id = tid + 512 * i; *(LAS u32x4*)(Vs + (id >> 6) * VS_STRIDE + (id & 63) * 8) = pre[i]; }
#pragma unroll
        for (int i = 0; i < 4; ++i) { const int id = tid + 512 * i; *(LAS u32x4*)(Kk + (id >> 5) * 256 + (id & 31) * 8) = pre[8 + i]; }
        float lr[16], wup[16];
        { const f32x4* p = (const f32x4*)(c.gklr + (size_t)(tok0 + lane) * 16);
#pragma unroll
          for (int q = 0; q < 4; ++q) { const f32x4 v = p[q]; lr[4 * q] = v[0]; lr[4 * q + 1] = v[1]; lr[4 * q + 2] = v[2]; lr[4 * q + 3] = v[3]; } }
#pragma unroll
        for (int q = 0; q < 16; ++q) wup[q] = c.w_gk_up[q * 256 + h * 64 + d];
        const float bg = c.b_gk[h * 64 + d];
        { const int nx = item + gridDim.x;
          if (nx < 512) { const int t0n = (nx >> 7) * SEQ + (nx & 127) * 64;
#pragma unroll
            for (int i = 0; i < 8; ++i) { const int id = tid + 512 * i; pre[i] = *(const u32x4*)(c.proj + PB_V + (size_t)(t0n + (id >> 6)) * 512 + (id & 63) * 8); }
#pragma unroll
            for (int i = 0; i < 4; ++i) { const int id = tid + 512 * i; pre[8 + i] = *(const u32x4*)(c.proj + PB_K + (size_t)(t0n + (id >> 5)) * 256 + (id & 31) * 8); } } }
        float bl[32]; float bsum = 0.f;
#pragma unroll
        for (int j = 0; j < 32; ++j) {
            float logit = bg;
#pragma unroll
            for (int q = 0; q < 16; ++q) logit = fmaf(__int_as_float(__builtin_amdgcn_readlane(__float_as_int(lr[q]), half * 32 + j)), wup[q], logit);
            const float ls = fminf(logit, 0.f) - __logf(1.f + __expf(-fabsf(logit)));
            bsum += ls * 0.0625f; bl[j] = bsum;
        }
        if (half == 0) totS[h * 64 + d] = bsum;
        __syncthreads();
        {
            const float off = half ? totS[h * 64 + d] : 0.f;
            u16* bp = c.bcum + (size_t)(tok0 + half * 32) * 256 + h * 64 + d;
            LAS u16* kd = kdT + h * 4608 + d * 72 + half * 32;
            const LAS u16* kk = Kk + half * 32 * 256 + h * 64 + d;
#pragma unroll
            for (int j = 0; j < 32; ++j) { const float bb = off + bl[j]; bp[(size_t)j * 256] = __builtin_bit_cast(u16, (_Float16)bb); kd[j] = f2bf(bf2f(kk[j * 256]) * __expf(-bb)); }
            if (half) { const float dec = __expf(off + bsum); c.dec[(size_t)((b * 4 + h) * 128 + n) * 64 + d] = dec; decS[h * 64 + d] = dec; }
        }
        __syncthreads();
        {
            const int mp = half;
            bf16x8 fb[2][4];
#pragma unroll
            for (int nt = 0; nt < 2; ++nt)
#pragma unroll
                for (int s = 0; s < 4; ++s) fb[nt][s] = *(const LAS bf16x8*)(kdT + h * 4608 + (nt * 32 + r) * 72 + 16 * s + 8 * hs);
            const float dec0 = decS[h * 64 + r], dec1 = decS[h * 64 + 32 + r];
            u16* cso = c.cs + (size_t)((b * 4 + h) * 128 + n) * 8192;
#pragma unroll
            for (int mi = 0; mi < 2; ++mi) {
                const int mt = mp * 2 + mi;
                f32x16 a0 = zero16(), a1 = zero16();
#pragma unroll
                for (int s = 0; s < 4; ++s) {
                    const bf16x8 av = tr_frag(Vs, VS_STRIDE, 16 * s + 8 * hs, 16 * s + 8 * hs + 4, h * 128 + mt * 32, lane);
                    a0 = mfma32(av, fb[0][s], a0); a1 = mfma32(av, fb[1][s], a1);
                }
#pragma unroll
                for (int i = 0; i < 16; ++i) { const int e = mt * 32 + crow(i, hs); cso[e * 64 + r] = f2bf(a0[i] * dec0); cso[e * 64 + 32 + r] = f2bf(a1[i] * dec1); }
            }
        }
        __syncthreads();
    }
}

DI void phase_scan(const Ctx& c, LAS unsigned char* lds) {
    int tid_l = threadIdx.x; asm volatile("" : "+v"(tid_l)); const int tid = tid_l;
    LAS float* decL = (LAS float*)lds;
    for (int blk = blockIdx.x; blk < 256; blk += gridDim.x) {
        const int bh = blk >> 4, idx = ((blk & 15) * 256 + (tid & 255)) * 2, d = idx & 63;
#pragma unroll
        for (int i = 0; i < 4; ++i) { const int id = tid + 512 * i; *(LAS f32x4*)(decL + id * 4) = *(const f32x4*)(c.dec + (size_t)bh * 8192 + id * 4); }
        unsigned* p = (unsigned*)(c.cs + (size_t)bh * 128 * 8192 + idx);
        unsigned cv[128];
        if (tid < 256) {
#pragma unroll
            for (int n = 0; n < 128; ++n) cv[n] = p[(size_t)n * 4096];
        }
        __syncthreads();
        if (tid < 256) {
            float S0 = 0.f, S1 = 0.f;
#pragma unroll
            for (int n = 0; n < 128; ++n) { const f32x2 dc = *(const LAS f32x2*)(decL + n * 64 + d); p[(size_t)n * 4096] = pk2(S0, S1); S0 = fmaf(dc[0], S0, lo16(cv[n])); S1 = fmaf(dc[1], S1, hi16(cv[n])); }
        }
        __syncthreads();
    }
}

template <int W> DI void pool_item(const Ctx& c, int g, int span0, int lane) {
    const int hs = lane >> 5, r = lane & 31;
    const int pos0 = span0 & (SEQ - 1);
#pragma unroll 1
    for (int nt = 0; nt < 2; ++nt) {
        bf16x8 fb[4];
#pragma unroll
        for (int s = 0; s < 4; ++s) { const float* wp = c.pool_w + (size_t)(g * 64 + 16 * s + 8 * hs) * 64 + nt * 32 + r;
            u32x4 w; w.x = pk2(wp[0], wp[64]); w.y = pk2(wp[128], wp[192]); w.z = pk2(wp[256], wp[320]); w.w = pk2(wp[384], wp[448]); fb[s] = __builtin_bit_cast(bf16x8, w); }
        const float ps = c.pool_scale[g * 64 + nt * 32 + r];
        float prev[16];
#pragma unroll
        for (int i = 0; i < 16; ++i) prev[i] = 0.f;
#pragma unroll 1
        for (int tt = (pos0 == 0 ? 0 : -1); tt < 2; ++tt) {
            const int tok0 = span0 + tt * 32;
            f32x16 z = zero16();
#pragma unroll
            for (int s = 0; s < 4; ++s) z = mfma32(*(const bf16x8*)(c.proj + PB_UP + (size_t)(tok0 + r) * 256 + g * 64 + 16 * s + 8 * hs), fb[s], z);
            float full[32];
#pragma unroll
            for (int i = 0; i < 16; ++i) { const float o = shx(z[i], 32); full[crow(i, 0)] = hs ? o : z[i]; full[crow(i, 1)] = hs ? z[i] : o; }
            if (tt >= 0) {
                float P[48];
                P[0] = prev[0];
#pragma unroll
                for (int k = 1; k < 16; ++k) P[k] = P[k - 1] + prev[k];
#pragma unroll
                for (int k = 0; k < 32; ++k) P[16 + k] = P[15 + k] + full[k];
#pragma unroll
                for (int i = 0; i < 16; ++i) {
                    const int t0 = crow(i, 0), t1 = crow(i, 1), t = hs ? t1 : t0;
                    const float ws = hs ? (P[t1 + 16] - P[t1 + 16 - W]) : (P[t0 + 16] - P[t0 + 16 - W]);
                    const int pos = pos0 + tt * 32 + t;
                    const float cinv = 1.f / (float)(pos + 1 < W ? pos + 1 : W);
                    const float val = ws * cinv - z[i];
                    const size_t tok = (size_t)(tok0 + t);
                    const float gate = bf2f(c.proj[PB_GP + tok * 256 + g * 64 + nt * 32 + r]);
                    c.mixed[tok * DM + 512 + g * 64 + nt * 32 + r] = f2bf(val * ps * silu(gate));
                }
            }
#pragma unroll
            for (int k = 0; k < 16; ++k) prev[k] = full[16 + k];
        }
    }
}
DI void phase_pool(const Ctx& c) {
    int tid_l = threadIdx.x; asm volatile("" : "+v"(tid_l)); const int tid = tid_l, wave = tid >> 6, lane = tid & 63;
    for (int gw = blockIdx.x * 8 + wave; gw < 2048; gw += gridDim.x * 8) {
        const int g = gw & 3, span0 = (gw >> 2) * 64;
        if (g == 0) pool_item<2>(c, 0, span0, lane); else if (g == 1) pool_item<4>(c, 1, span0, lane); else if (g == 2) pool_item<8>(c, 2, span0, lane); else pool_item<16>(c, 3, span0, lane);
    }
}

DI void phase_memattn(const Ctx& c, LAS unsigned char* lds) {
    int tid_l = threadIdx.x; asm volatile("" : "+v"(tid_l)); const int tid = tid_l, wave = tid >> 6, lane = tid & 63, hs = lane >> 5, r = lane & 31;
    LAS u16* Ks = (LAS u16*)lds;
    LAS u16* Vt = (LAS u16*)(lds + 256 * 72 * 2);
    for (int unit = blockIdx.x; unit < 256; unit += gridDim.x) {
        const int b = unit >> 6, hm = (unit >> 4) & 3, tokbase = b * SEQ + (unit & 15) * 512;
        bf16x8 qf[2][4]; u32x4 gv[2][4];
#pragma unroll
        for (int ti = 0; ti < 2; ++ti) { const size_t tok = (size_t)(tokbase + (wave * 2 + ti) * 32 + r);
#pragma unroll
            for (int s = 0; s < 4; ++s) qf[ti][s] = *(const bf16x8*)(c.proj + PB_QM + tok * 256 + hm * 64 + 16 * s + 8 * hs);
#pragma unroll
            for (int g8 = 0; g8 < 4; ++g8) gv[ti][g8] = *(const u32x4*)(c.proj + PB_GM + tok * 256 + hm * 64 + 16 * g8 + 8 * hs); }
        { const int row = tid >> 1, half = tid & 1; const u16* src = c.kv + (size_t)(b * 256 + row) * 512 + hm * 64 + half * 32;
#pragma unroll
          for (int q = 0; q < 4; ++q) *(LAS u32x4*)(Ks + row * 72 + half * 32 + q * 8) = *(const u32x4*)(src + q * 8); }
        { const int m = tid & 255, dvh = tid >> 8; const u16* src = c.kv + (size_t)(b * 256 + m) * 512 + 256 + hm * 64 + dvh * 32;
#pragma unroll
          for (int q = 0; q < 4; ++q) { const u32x4 v = *(const u32x4*)(src + q * 8);
#pragma unroll
              for (int j = 0; j < 4; ++j) { Vt[(dvh * 32 + q * 8 + 2 * j) * 260 + m] = (u16)(v[j] & 0xffffu); Vt[(dvh * 32 + q * 8 + 2 * j + 1) * 260 + m] = (u16)(v[j] >> 16); } } }
        __syncthreads();
#pragma unroll
        for (int ti = 0; ti < 2; ++ti) {
            const int tok = tokbase + (wave * 2 + ti) * 32 + r;
            float mrun = -3.0e38f, lsum = 0.f;
            f32x16 O0 = zero16(), O1 = zero16();
#pragma unroll 1
            for (int hf = 0; hf < 2; ++hf) {
                f32x16 X[4];
#pragma unroll
                for (int mq = 0; mq < 4; ++mq) { X[mq] = zero16();
#pragma unroll
                    for (int s = 0; s < 4; ++s) X[mq] = mfma32(*(const LAS bf16x8*)(Ks + ((hf * 4 + mq) * 32 + r) * 72 + 16 * s + 8 * hs), qf[ti][s], X[mq]); }
                float mx = -3.0e38f;
#pragma unroll
                for (int mq = 0; mq < 4; ++mq)
#pragma unroll
                    for (int i = 0; i < 16; ++i) mx = fmaxf(mx, X[mq][i]);
                mx = fmaxf(mx, shx(mx, 32));
                const float mnew = fmaxf(mrun, mx), alpha = exp2f((mrun - mnew) * 0.18033688f);
                mrun = mnew; lsum *= alpha;
#pragma unroll
                for (int i = 0; i < 16; ++i) { O0[i] *= alpha; O1[i] *= alpha; }
#pragma unroll
                for (int mq = 0; mq < 4; ++mq)
#pragma unroll
                    for (int i = 0; i < 16; ++i) { const float p = exp2f((X[mq][i] - mnew) * 0.18033688f); X[mq][i] = p; lsum += p; }
#pragma unroll
                for (int mq = 0; mq < 4; ++mq)
#pragma unroll
                    for (int s2 = 0; s2 < 2; ++s2) {
                        u32x4 pb; pb.x = pk2(X[mq][8 * s2], X[mq][8 * s2 + 1]); pb.y = pk2(X[mq][8 * s2 + 2], X[mq][8 * s2 + 3]); pb.z = pk2(X[mq][8 * s2 + 4], X[mq][8 * s2 + 5]); pb.w = pk2(X[mq][8 * s2 + 6], X[mq][8 * s2 + 7]);
                        const int mo = (hf * 4 + mq) * 32 + 16 * s2 + 4 * hs;
                        const u32x2 a00 = *(const LAS u32x2*)(Vt + r * 260 + mo), a01 = *(const LAS u32x2*)(Vt + r * 260 + mo + 8);
                        const u32x2 a10 = *(const LAS u32x2*)(Vt + (32 + r) * 260 + mo), a11 = *(const LAS u32x2*)(Vt + (32 + r) * 260 + mo + 8);
                        const u32x4 A0 = {a00.x, a00.y, a01.x, a01.y}, A1 = {a10.x, a10.y, a11.x, a11.y};
                        O0 = mfma32(__builtin_bit_cast(bf16x8, A0), __builtin_bit_cast(bf16x8, pb), O0);
                        O1 = mfma32(__builtin_bit_cast(bf16x8, A1), __builtin_bit_cast(bf16x8, pb), O1);
                    }
            }
            lsum += shx(lsum, 32);
            const float inv = 1.f / lsum;
            u16* mp = c.mixed + (size_t)tok * DM + 768 + hm * 64;
#pragma unroll
            for (int dvt = 0; dvt < 2; ++dvt)
#pragma unroll
                for (int jp = 0; jp < 2; ++jp) {
                    const u32x4 gq = gv[ti][dvt * 2 + jp];
                    unsigned ga[2] = {gq.x, gq.z}, gb[2] = {gq.y, gq.w};
                    swap32(ga[0], ga[1]); swap32(gb[0], gb[1]);
                    unsigned wx[2], wy[2];
#pragma unroll
                    for (int k = 0; k < 2; ++k) { const int g4 = 2 * jp + k;
                        const float o0 = dvt ? O1[4 * g4] : O0[4 * g4], o1 = dvt ? O1[4 * g4 + 1] : O0[4 * g4 + 1], o2 = dvt ? O1[4 * g4 + 2] : O0[4 * g4 + 2], o3 = dvt ? O1[4 * g4 + 3] : O0[4 * g4 + 3];
                        wx[k] = pk2(o0 * inv * silu(lo16(ga[k])), o1 * inv * silu(hi16(ga[k]))); wy[k] = pk2(o2 * inv * silu(lo16(gb[k])), o3 * inv * silu(hi16(gb[k]))); }
                    swap32(wx[0], wx[1]); swap32(wy[0], wy[1]);
                    const u32x4 o = {wx[0], wy[0], wx[1], wy[1]};
                    *(u32x4*)(mp + dvt * 32 + 16 * jp + 8 * hs) = o; }
        }
        __syncthreads();
    }
}

DI void gla_frags(const Ctx& c, size_t row, int c8, bf16x8 (&qd)[4], bf16x8 (&kd)[4], int hs) {
#pragma unroll
    for (int s = 0; s < 4; ++s) {
        const int cc = c8 + 16 * s + 8 * hs;
        const u32x4 qv = *(const u32x4*)(c.proj + PB_Q + row * 256 + cc), kv = *(const u32x4*)(c.proj + PB_K + row * 256 + cc);
        const f32x8 bb = __builtin_convertvector(*(const h16x8*)(c.bcum + row * 256 + cc), f32x8);
        u32x4 qo, ko;
#pragma unroll
        for (int q = 0; q < 4; ++q) { const float e0 = __expf(bb[2 * q]), e1 = __expf(bb[2 * q + 1]);
            qo[q] = pk2(lo16(qv[q]) * 0.125f * e0, hi16(qv[q]) * 0.125f * e1);
            ko[q] = pk2(lo16(kv[q]) * __expf(-bb[2 * q]), hi16(kv[q]) * __expf(-bb[2 * q + 1])); }
        qd[s] = __builtin_bit_cast(bf16x8, qo); kd[s] = __builtin_bit_cast(bf16x8, ko);
    }
}
DI void pack_x(const f32x16& X, u32x4 (&pb)[2]) {
#pragma unroll
    for (int s2 = 0; s2 < 2; ++s2) { pb[s2].x = pk2(X[8 * s2], X[8 * s2 + 1]); pb[s2].y = pk2(X[8 * s2 + 2], X[8 * s2 + 3]); pb[s2].z = pk2(X[8 * s2 + 4], X[8 * s2 + 5]); pb[s2].w = pk2(X[8 * s2 + 6], X[8 * s2 + 7]); }
}
DI void phase_gla_out(const Ctx& c, LAS unsigned char* lds, int item0, int item1) {
    int tid_l = threadIdx.x; asm volatile("" : "+v"(tid_l)); const int tid = tid_l, wave = tid >> 6, lane = tid & 63, hs = lane >> 5, r = lane & 31;
    LAS u16* Vs = (LAS u16*)lds;
    LAS u16* Ss = (LAS u16*)(lds + VS_BYTES);
    for (int item = item0; item < item1; item += gridDim.x) {
        const int b = item >> 7, n = item & 127, tok0 = b * SEQ + n * 64;
        const int h = wave >> 1, it = wave & 1;
#pragma unroll
        for (int i = 0; i < 8; ++i) { const int id = tid + 512 * i, row = id >> 6, cc = id & 63;
            *(LAS u32x4*)(Vs + row * VS_STRIDE + cc * 8) = *(const u32x4*)(c.proj + PB_V + (size_t)(tok0 + row) * 512 + cc * 8); }
#pragma unroll
        for (int i = 0; i < 8; ++i) { const int id = tid + 512 * i, hh = id >> 10, e = (id >> 3) & 127, cc = id & 7;
            *(LAS u32x4*)(Ss + (hh * 128 + e) * 72 + cc * 8) = *(const u32x4*)(c.cs + (size_t)((b * 4 + hh) * 128 + n) * 8192 + e * 64 + cc * 8); }
        bf16x8 qd[4], kdc[4], kd0[4];
        gla_frags(c, (size_t)(tok0 + it * 32 + r), h * 64, qd, kdc, hs);
        if (it == 1) { bf16x8 qx[4]; gla_frags(c, (size_t)(tok0 + r), h * 64, qx, kd0, hs); }
        f32x16 Xd = zero16(), Xo = zero16();
#pragma unroll
        for (int s = 0; s < 4; ++s) Xd = mfma32(kdc[s], qd[s], Xd);
        if (it == 1) {
#pragma unroll
            for (int s = 0; s < 4; ++s) Xo = mfma32(kd0[s], qd[s], Xo);
        }
#pragma unroll
        for (int i = 0; i < 16; ++i) if (crow(i, hs) > r) Xd[i] = 0.f;
        u32x4 pbd[2], pbo[2];
        pack_x(Xd, pbd); pack_x(Xo, pbo);
        const size_t tok = (size_t)(tok0 + it * 32 + r);
        const u16* gp = c.proj + PB_GG + tok * 512 + h * 128; u16* mp = c.mixed + tok * DM + h * 128;
        u32x4 gvq[8];
#pragma unroll
        for (int q = 0; q < 8; ++q) gvq[q] = *(const u32x4*)(gp + 16 * q + 8 * hs);
        __syncthreads();
        f32x16 O[4];
#pragma unroll
        for (int mt = 0; mt < 4; ++mt) {
            O[mt] = zero16();
#pragma unroll
            for (int s2 = 0; s2 < 2; ++s2)
                O[mt] = mfma32(tr_frag(Vs, VS_STRIDE, it * 32 + 16 * s2 + 4 * hs, it * 32 + 16 * s2 + 8 + 4 * hs, h * 128 + mt * 32, lane), __builtin_bit_cast(bf16x8, pbd[s2]), O[mt]);
            if (it == 1) {
#pragma unroll
                for (int s2 = 0; s2 < 2; ++s2)
                    O[mt] = mfma32(tr_frag(Vs, VS_STRIDE, 16 * s2 + 4 * hs, 16 * s2 + 8 + 4 * hs, h * 128 + mt * 32, lane), __builtin_bit_cast(bf16x8, pbo[s2]), O[mt]);
            }
#pragma unroll
            for (int s = 0; s < 4; ++s) O[mt] = mfma32(*(const LAS bf16x8*)(Ss + (h * 128 + mt * 32 + r) * 72 + 16 * s + 8 * hs), qd[s], O[mt]);
        }
        float ss = 0.f;
#pragma unroll
        for (int mt = 0; mt < 4; ++mt)
#pragma unroll
            for (int i = 0; i < 16; ++i) ss += O[mt][i] * O[mt][i];
        ss += shx(ss, 32);
        const float rn = rsqrtf(ss * (1.f / 128.f) + EPS);
#pragma unroll
        for (int mt = 0; mt < 4; ++mt)
#pragma unroll
            for (int jp = 0; jp < 2; ++jp) {
                const u32x4 gq = gvq[mt * 2 + jp];
                unsigned ga[2] = {gq.x, gq.z}, gb[2] = {gq.y, gq.w};
                swap32(ga[0], ga[1]); swap32(gb[0], gb[1]);
                unsigned wx[2], wy[2];
#pragma unroll
                for (int k = 0; k < 2; ++k) { const int g4 = 2 * jp + k, e0 = mt * 32 + 8 * g4 + 4 * hs; const f32x4 ng = *(const f32x4*)(c.gla_norm_g + e0);
                    wx[k] = pk2(O[mt][4 * g4] * rn * ng[0] * silu(lo16(ga[k])), O[mt][4 * g4 + 1] * rn * ng[1] * silu(hi16(ga[k])));
                    wy[k] = pk2(O[mt][4 * g4 + 2] * rn * ng[2] * silu(lo16(gb[k])), O[mt][4 * g4 + 3] * rn * ng[3] * silu(hi16(gb[k]))); }
                swap32(wx[0], wx[1]); swap32(wy[0], wy[1]);
                const u32x4 o = {wx[0], wy[0], wx[1], wy[1]};
                *(u32x4*)(mp + mt * 32 + 16 * jp + 8 * hs) = o; }
        __syncthreads();
    }
}

#define XB_TMO      128
#define XB_XCNT(j)  (256  + 64 * (j))
#define XB_XSUB(j)  (1280 + 64 * (j))
#define XB_XGEN(j)  (2304 + 64 * (j))
#define XB_TOP      3328
#define XB_TOPGEN   3392
#define XCD_BAR_WORDS 3456
#define XB_SPIN_CAP (1u << 20)
DI unsigned xb_ld(unsigned* p)              { return __hip_atomic_load(p, __ATOMIC_RELAXED, __HIP_MEMORY_SCOPE_AGENT); }
DI unsigned xb_add(unsigned* p, unsigned v) { return __hip_atomic_fetch_add(p, v, __ATOMIC_RELAXED, __HIP_MEMORY_SCOPE_AGENT); }
DI unsigned xb_xcc_id() { return (unsigned)__builtin_amdgcn_s_getreg((3 << 11) | 20) & 0xFu; }
#define XB_SPIN(cond, bar) do { unsigned _sp = 0; while (cond) { __builtin_amdgcn_s_sleep(1); \
    if ((++_sp & 255u) == 0u) { if (xb_ld(&(bar)[XB_TMO])) break; if (_sp > XB_SPIN_CAP) { atomicAdd(&(bar)[XB_TMO], 1u); break; } } } } while (0)
struct XcdBarrier { unsigned* bar; unsigned x; volatile LAS unsigned* st; };
DI XcdBarrier xcd_barrier_post(unsigned* bar, volatile LAS unsigned* st) {
    XcdBarrier b; b.bar = bar; b.x = xb_xcc_id(); b.st = st;
    if (threadIdx.x == 0) (void)xb_add(&bar[XB_XCNT(b.x)], 1u);
    return b;
}
DI void xcd_barrier_complete(unsigned* bar, unsigned x, unsigned& nloc, unsigned& nx) {
    const unsigned G = gridDim.x * gridDim.y * gridDim.z;
    unsigned sum, cnt, mine, sp = 0u;
    for (;;) {
        sum = 0u; cnt = 0u; mine = 0u;
#pragma unroll
        for (unsigned j = 0; j < 16; ++j) { const unsigned cc = xb_ld(&bar[XB_XCNT(j)]); sum += cc; cnt += (cc > 0u) ? 1u : 0u; mine = (j == x) ? cc : mine; }
        if (sum == G) break;
        __builtin_amdgcn_s_sleep(1);
        if ((++sp & 255u) == 0u) { if (xb_ld(&bar[XB_TMO])) break; if (sp > XB_SPIN_CAP) { atomicAdd(&bar[XB_TMO], 1u); break; } }
    }
    nloc = mine > 0u ? mine : 1u; nx = cnt > 0u ? cnt : 1u;
}
DI void xsb_arrive(const XcdBarrier& b) {
    asm volatile("s_waitcnt vmcnt(0)" ::: "memory");
    __syncthreads();
    if (threadIdx.x == 0) {
        unsigned* bar = b.bar;
        unsigned nloc = b.st[0], nx = b.st[1];
        if (nloc == 0u) { xcd_barrier_complete(bar, b.x, nloc, nx); b.st[0] = nloc; b.st[1] = nx; }
        const unsigned old = xb_add(&bar[XB_XSUB(b.x)], 1u);
        const unsigned gen = old / nloc;
        if (old + 1u == (gen + 1u) * nloc) {
            __builtin_amdgcn_fence(__ATOMIC_RELEASE, "agent");
            asm volatile("s_waitcnt vmcnt(0)" ::: "memory");
            (void)xb_add(&bar[XB_TOP], 1u);
        }
    }
}
DI void xsb_wait(const XcdBarrier& b, unsigned round) {
    if (threadIdx.x == 0) {
        unsigned* bar = b.bar;
        const unsigned need = round * b.st[1];
        XB_SPIN(xb_ld(&bar[XB_TOP]) < need, bar);
        __builtin_amdgcn_fence(__ATOMIC_ACQUIRE, "agent");
        asm volatile("s_waitcnt vmcnt(0)" ::: "memory");
    }
    __syncthreads();
}

__global__ void __launch_bounds__(512, 2) hybrid_fwd(Ctx c) {
    extern __shared__ __attribute__((aligned(16))) unsigned char lds_raw[];
    LAS unsigned char* lds = (LAS unsigned char*)lds_raw;
    volatile LAS unsigned* xst = (volatile LAS unsigned*)(lds + 144 * 1024);
    if (threadIdx.x == 0) { xst[0] = 0u; xst[1] = 0u; xst[2] = 0u; xst[3] = 0u; }
    __syncthreads();
    const XcdBarrier xb = xcd_barrier_post(c.bar, xst);
    const XcdBarrier xb2 = xcd_barrier_post(c.bar + XCD_BAR_WORDS + 8192, xst + 2);
    phase_prep(c, lds, 0); __syncthreads();
    xsb_arrive(xb);
    phase_prep(c, lds, 2); __syncthreads();
    xsb_wait(xb, 1u);
    const bool kv_first = ((blockIdx.x >> 3) & 1) != 0;
    if (kv_first) { phase_prep(c, lds, 1); __syncthreads(); }
    { pg8::Gemm g{c.Hb, c.WiT, NTOK, NMAIN, DM}; pg8::StaticOrder S; S.init(NTOK, NMAIN, (int)gridDim.x, (int)blockIdx.x); EpiProj E{c.proj, c.rs}; pg8::gemm_phase<EpiProj>(lds, g, S, E); __syncthreads(); }
    xsb_arrive(xb);
    if (!kv_first) { phase_prep(c, lds, 1); __syncthreads(); }
    xsb_wait(xb, 2u);
    phase_gla_cs(c, lds); __syncthreads();
    xsb_arrive(xb);
    phase_pool(c);
    xsb_wait(xb, 3u);
    phase_scan(c, lds);
    xsb_arrive(xb);
    phase_memattn(c, lds);
    xsb_wait(xb, 4u);
    phase_gla_out(c, lds, (int)blockIdx.x, 256); __syncthreads();
    xsb_arrive(xb);
    phase_gla_out(c, lds, 256 + (int)blockIdx.x, 512); __syncthreads();
    xsb_arrive(xb2);
    xsb_wait(xb, 5u);
    for (int half = 0; half < 2; ++half) {
        if (half == 1) xsb_wait(xb2, 1u);
        pg8::Gemm g{c.mixed + (size_t)half * 16384 * DM, c.WoT, 16384, DM, DM}; pg8::StaticOrder S; S.init(16384, DM, (int)gridDim.x, (int)blockIdx.x);
        EpiOutNorm E{c.Hb, c.out, c.final_g, c.slots, c.bar + XCD_BAR_WORDS, c.bar + XB_TMO, half * 16384, half * 64};
        pg8::gemm_phase<EpiOutNorm>(lds, g, S, E);
    }
}

constexpr size_t LDS_XST = 144 * 1024;
constexpr size_t LDS_BYTES = LDS_XST + 16;
extern "C" void kernel_launch(void* const* d_in, const int* in_sizes, int n_in, void* d_out, int out_size, void* d_ws, size_t ws_size, hipStream_t stream) {
    static int grid_blocks = 0;
    if (!grid_blocks) {
        int dev = 0, cus = 0, per_cu = 0;
        hipGetDevice(&dev);
        hipDeviceGetAttribute(&cus, hipDeviceAttributeMultiprocessorCount, dev);
        hipFuncSetAttribute((const void*)hybrid_fwd, hipFuncAttributeMaxDynamicSharedMemorySize, (int)LDS_BYTES);
        hipOccupancyMaxActiveBlocksPerMultiprocessor(&per_cu, (const void*)hybrid_fwd, 512, LDS_BYTES);
        if (per_cu < 1) { fprintf(stderr, "occupancy query says %d blocks per CU\n", per_cu); per_cu = 1; }
        if (per_cu > 1) per_cu = 1;
        grid_blocks = cus * per_cu;
        if (grid_blocks != 256) fprintf(stderr, "this kernel is built for a 256-CU device (grid %d)\n", grid_blocks);
    }
    Ctx c{};
    c.x = (const float*)d_in[0]; c.mem = (const float*)d_in[1]; c.norm_g = (const float*)d_in[2]; c.w_in = (const float*)d_in[3]; c.w_gk_up = (const float*)d_in[4];
    c.b_gk = (const float*)d_in[5]; c.gla_norm_g = (const float*)d_in[6]; c.pool_w = (const float*)d_in[7]; c.pool_scale = (const float*)d_in[8]; c.mem_norm_g = (const float*)d_in[9];
    c.w_mem_kv = (const float*)d_in[10]; c.w_out = (const float*)d_in[11]; c.final_g = (const float*)d_in[12];
    c.out = (float*)d_out;
    unsigned char* w = (unsigned char*)d_ws; size_t off = 0;
    auto take = [&](size_t bytes) { unsigned char* p = w + off; off += (bytes + 255) & ~(size_t)255; return p; };
    c.WiT = (u16*)take((size_t)NMAIN * 1024 * 2); c.WoT = (u16*)take((size_t)1024 * 1024 * 2); c.Hb = (u16*)take((size_t)NTOK * 1024 * 2);
    c.kv = (u16*)take((size_t)1024 * 512 * 2); c.proj = (u16*)take((size_t)NTOK * NMAIN * 2); c.cs = (u16*)take((size_t)2048 * 8192 * 2); c.mixed = (u16*)take((size_t)NTOK * 1024 * 2);
    c.rs = (float*)take((size_t)NTOK * 4); c.gklr = (float*)take((size_t)NTOK * 16 * 4); c.bcum = (u16*)take((size_t)NTOK * 256 * 2); c.dec = (float*)take((size_t)2048 * 64 * 4);
    c.bar = (unsigned*)take((size_t)(2 * XCD_BAR_WORDS + 8192) * 4); c.slots = (float*)take((size_t)128 * 4 * 256 * 4);
    if (off > ws_size) { fprintf(stderr, "workspace too small: need %zu have %zu\n", off, ws_size); return; }
    if (hipMemsetAsync(c.bar, 0, (size_t)(2 * XCD_BAR_WORDS + 8192) * 4, stream) != hipSuccess) { fprintf(stderr, "memset failed\n"); return; }
    void* args[] = {&c};
    hipError_t e = hipLaunchCooperativeKernel((const void*)hybrid_fwd, dim3(grid_blocks), dim3(512), args, (unsigned)LDS_BYTES, stream);
    if (e != hipSuccess) fprintf(stderr, "cooperative launch failed: %s (grid %d)\n", hipGetErrorString(e), grid_blocks);
}
```

```cpp
#include <hip/hip_runtime.h>
#include <cstdio>

#define DI __device__ __forceinline__
#define LAS __attribute__((address_space(3)))
typedef unsigned short u16;
typedef short bf16x8 __attribute__((ext_vector_type(8)));
typedef float f32x4 __attribute__((ext_vector_type(4)));
typedef float f32x2 __attribute__((ext_vector_type(2)));
typedef float f32x16 __attribute__((ext_vector_type(16)));
typedef unsigned u32x4 __attribute__((ext_vector_type(4)));
typedef unsigned u32x2 __attribute__((ext_vector_type(2)));
typedef __bf16 bfv2 __attribute__((ext_vector_type(2)));
typedef _Float16 h16x8 __attribute__((ext_vector_type(8)));
typedef float f32x8 __attribute__((ext_vector_type(8)));

constexpr int NTOK = 32768, DM = 1024, DIN = 2576, NMAIN = 2560, SEQ = 8192;
constexpr int C_Q = 0, C_K = 256, C_V = 512, C_GG = 1024, C_UP = 1536, C_GP = 1792, C_QM = 2048, C_GM = 2304;
constexpr size_t PB_Q = (size_t)NTOK * C_Q, PB_K = (size_t)NTOK * C_K, PB_V = (size_t)NTOK * C_V, PB_GG = (size_t)NTOK * C_GG, PB_UP = (size_t)NTOK * C_UP, PB_GP = (size_t)NTOK * C_GP, PB_QM = (size_t)NTOK * C_QM, PB_GM = (size_t)NTOK * C_GM;
constexpr float EPS = 1e-6f;

struct Ctx {
    const float *x, *mem, *norm_g, *w_in, *w_gk_up, *b_gk, *gla_norm_g, *pool_w, *pool_scale, *mem_norm_g, *w_mem_kv, *w_out, *final_g;
    float* out;
    u16 *WiT, *WoT, *Hb, *kv, *proj, *cs, *mixed;
    float *rs, *gklr, *dec;
    u16* bcum;
    unsigned* bar; float* slots;
};

DI float bf2f(u16 b) { return __uint_as_float((unsigned)b << 16); }
DI unsigned pk2(float a, float b) { f32x2 v = {a, b}; bfv2 r = __builtin_convertvector(v, bfv2); return __builtin_bit_cast(unsigned, r); }
DI u16 f2bf(float a) { return (u16)(pk2(a, 0.f) & 0xffffu); }
DI float lo16(unsigned w) { return __uint_as_float(w << 16); }
DI float hi16(unsigned w) { return __uint_as_float(w & 0xffff0000u); }
DI float silu(float v) { return v / (1.f + __expf(-v)); }
DI int crow(int reg, int h) { return (reg & 3) + 8 * (reg >> 2) + 4 * h; }
DI f32x16 mfma32(bf16x8 a, bf16x8 b, f32x16 c) { return __builtin_amdgcn_mfma_f32_32x32x16_bf16(a, b, c, 0, 0, 0); }
DI f32x4 mfma16(bf16x8 a, bf16x8 b, f32x4 c) { return __builtin_amdgcn_mfma_f32_16x16x32_bf16(a, b, c, 0, 0, 0); }
DI f32x16 zero16() { f32x16 z; for (int i = 0; i < 16; ++i) z[i] = 0.f; return z; }
DI float shx(float v, int m) { return __shfl_xor(v, m); }
typedef short v4i16_t __attribute__((ext_vector_type(4)));
DI void swap32(unsigned& a, unsigned& b) { const auto r = __builtin_amdgcn_permlane32_swap(a, b, false, false); a = r[0]; b = r[1]; }
DI v4i16_t vtr(const LAS u16* p) { return __builtin_amdgcn_ds_read_tr16_b64_v4i16((LAS v4i16_t*)p); }
DI bf16x8 tr_frag(const LAS u16* img, int stride, int row_lo, int row_hi, int col0, int lane) {
    const int i16 = lane & 15, blk = (lane >> 4) & 1, q = i16 >> 2, p = i16 & 3;
    const v4i16_t lo = vtr(img + (row_lo + q) * stride + col0 + blk * 16 + 4 * p), hi = vtr(img + (row_hi + q) * stride + col0 + blk * 16 + 4 * p);
    return __builtin_shufflevector(lo, hi, 0, 1, 2, 3, 4, 5, 6, 7);
}

namespace pg8 {
constexpr int BM = 256, BK = 64, HALF = 128, HTB = HALF * BK * 2, STAGE_BYTES = 8 * HTB, NXCD = 8, WGM = 8;
DI int lds_byte(int r, int c) { const int st = (r >> 4) * 2 + (c >> 5), rr = r & 15, cc = c & 31, ob = rr * 64 + cc * 2; return st * 1024 + (ob ^ (((ob >> 9) & 1) << 5)); }
DI void stage_rc(int b, int& R, int& C) { const int st = b / 1024, sb = b % 1024, swz = sb ^ (((sb >> 9) & 1) << 5); R = (st >> 1) * 16 + swz / 64; C = (st & 1) * 32 + (swz % 64) / 2; }
DI int perm32(int rho) { const int n = rho >> 4, i = rho & 15; return 8 * (i >> 2) + 4 * n + (i & 3); }
struct Unit { int pm, pn; };
struct Gemm { const u16* A; const u16* Bt; int M, N, K; };
struct StaticOrder {
    int nM, nN, nwg, G, c;
    DI void init(int M, int N, int G_, int c_) { nM = M / BM; nN = N / BM; nwg = nM * nN; G = G_; c = c_; }
    DI bool next(int i, Unit& u) const {
        const long L = (long)i * G + c; if (L >= nwg) return false;
        int wgid = (int)L; { const int q = nwg / NXCD, r = nwg % NXCD, xcd = wgid % NXCD, off = wgid / NXCD; wgid = (xcd < r ? xcd * (q + 1) : r * (q + 1) + (xcd - r) * q) + off; }
        const int nig = WGM * nN, gid = wgid / nig, fm = gid * WGM, gsz = (nM - fm) < WGM ? (nM - fm) : WGM;
        u.pm = fm + ((wgid % nig) % gsz); u.pn = (wgid % nig) / gsz; return true;
    }
};

template <class Epi>
DI void gemm_phase(LAS unsigned char* lds, const Gemm g, const StaticOrder& S, const Epi& E) {
    int tid_l = threadIdx.x; asm volatile("" : "+v"(tid_l)); const int tid = tid_l, wid = __builtin_amdgcn_readfirstlane(tid >> 6), lane = tid & 63, wr = wid >> 2, wc = wid & 3, fr = lane & 15, fq = lane >> 4;
    const int K = g.K, nt = K / BK;
    unsigned voffA[2], voffB[2];
#pragma unroll
    for (int i = 0; i < 2; ++i) { int R, C; stage_rc(tid * 16 + i * 8192, R, C); const int Rb = Epi::PERM ? ((R & ~31) + perm32(R & 31)) : R;
        voffA[i] = (unsigned)(R * K + C) * 2u; voffB[i] = (unsigned)(Rb * K + C) * 2u; }
    const size_t kstep = (size_t)(BK * 2);
    const size_t hstep = (size_t)HALF * K * 2;
    const size_t tstep = 2 * hstep;
    const unsigned ldsw = (unsigned)wid * 1024u;
    const int aoff = lds_byte(wr * 64 + fr, fq * 8), boff = lds_byte(wc * 32 + fr, fq * 8);
#define PG8_SA(b, h) (((b) * 2 + (h)) * HTB)
#define PG8_SB(b, h) ((4 + (b) * 2 + (h)) * HTB)
#define PG8_STAGE(bufoff, gbase, voff) do { _Pragma("unroll") for (int _i = 0; _i < 2; ++_i) \
        __builtin_amdgcn_global_load_lds((const unsigned*)((const char*)(gbase) + (voff)[_i]), (LAS unsigned*)(lds + (bufoff) + ldsw + _i * 8192), 16, 0, 0); } while (0)
#define PG8_LDA(dst, b, h) do { _Pragma("unroll") for (int m = 0; m < 4; ++m) _Pragma("unroll") for (int k = 0; k < 2; ++k) dst[m][k] = *(const LAS bf16x8*)(lds + PG8_SA(b, h) + aoff + m * 2048 + k * 1024); } while (0)
#define PG8_LDB(dst, b, h) do { _Pragma("unroll") for (int n = 0; n < 2; ++n) _Pragma("unroll") for (int k = 0; k < 2; ++k) dst[n][k] = *(const LAS bf16x8*)(lds + PG8_SB(b, h) + boff + n * 2048 + k * 1024); } while (0)
#define PG8_MMA(ai, bj, At, Bt) do { __builtin_amdgcn_s_setprio(1); _Pragma("unroll") for (int m = 0; m < 4; ++m) _Pragma("unroll") for (int n = 0; n < 2; ++n) _Pragma("unroll") for (int k = 0; k < 2; ++k) \
        acc[ai][bj][m][n] = __builtin_amdgcn_mfma_f32_16x16x32_bf16(Bt[n][k], At[m][k], acc[ai][bj][m][n], 0, 0, 0); __builtin_amdgcn_s_setprio(0); } while (0)
#define PG8_WAIT_V(n) asm volatile("s_waitcnt vmcnt(" #n ")" ::: "memory")
#define PG8_WAIT_L(n) asm volatile("s_waitcnt lgkmcnt(" #n ")" ::: "memory")
#define PG8_BAR __builtin_amdgcn_s_barrier()
#define PG8_SCHED __builtin_amdgcn_sched_barrier(0)
    Unit cur, nxt; int ui = 0;
    if (!S.next(0, cur)) return;
    f32x4 acc[2][2][4][2];
#pragma unroll
    for (int a = 0; a < 2; ++a)
#pragma unroll
        for (int b = 0; b < 2; ++b)
#pragma unroll
            for (int m = 0; m < 4; ++m)
#pragma unroll
                for (int n = 0; n < 2; ++n) acc[a][b][m][n] = (f32x4){0.f, 0.f, 0.f, 0.f};
    bf16x8 At[4][2], B0[2][2], B1[2][2];
    const char* cA = (const char*)g.A + (size_t)cur.pm * tstep; const char* cB = (const char*)g.Bt + (size_t)cur.pn * tstep;
    float pre[8];
    if constexpr (Epi::PRELOAD) E.preload(cur, wr, fr, pre);
    PG8_STAGE(PG8_SB(0, 0), cB, voffB); PG8_STAGE(PG8_SA(0, 0), cA, voffA); PG8_STAGE(PG8_SB(0, 1), cB + hstep, voffB); PG8_STAGE(PG8_SA(0, 1), cA + hstep, voffA);
    if (wr == 1) PG8_BAR;
    PG8_WAIT_V(4); PG8_BAR;
    PG8_STAGE(PG8_SB(1, 0), cB + kstep, voffB); PG8_STAGE(PG8_SA(1, 0), cA + kstep, voffA); PG8_STAGE(PG8_SB(1, 1), cB + hstep + kstep, voffB);
    PG8_WAIT_V(6); PG8_BAR;
    for (;;) {
        const bool has_next = S.next(ui + 1, nxt);
        const char* nA = has_next ? (const char*)g.A + (size_t)nxt.pm * tstep : cA; const char* nB = has_next ? (const char*)g.Bt + (size_t)nxt.pn * tstep : cB;
        for (int t = 0; t < nt; t += 2) {
            const bool last = (t == nt - 2);
            const char* a1 = cA + (size_t)(t + 1) * kstep;
            const char* a2 = last ? nA : cA + (size_t)(t + 2) * kstep; const char* b2 = last ? nB : cB + (size_t)(t + 2) * kstep;
            const char* a3 = a2 + kstep; const char* b3 = b2 + kstep;
            PG8_LDB(B0, 0, 0); PG8_SCHED; PG8_LDA(At, 0, 0); PG8_STAGE(PG8_SA(1, 1), a1 + hstep, voffA);
            PG8_WAIT_L(8); PG8_BAR; PG8_WAIT_L(0); PG8_MMA(0, 0, At, B0); PG8_BAR; PG8_SCHED;
            PG8_LDB(B1, 0, 1); PG8_STAGE(PG8_SB(0, 0), b2, voffB);
            PG8_BAR; PG8_WAIT_L(0); PG8_MMA(0, 1, At, B1); PG8_BAR;
            PG8_LDA(At, 0, 1); PG8_STAGE(PG8_SA(0, 0), a2, voffA);
            PG8_BAR; PG8_WAIT_L(0); PG8_MMA(1, 0, At, B0); PG8_BAR; PG8_SCHED;
            PG8_STAGE(PG8_SB(0, 1), b2 + hstep, voffB);
            PG8_WAIT_V(6); PG8_BAR; PG8_MMA(1, 1, At, B1); PG8_BAR;
            PG8_LDB(B0, 1, 0); PG8_SCHED; PG8_LDA(At, 1, 0); PG8_STAGE(PG8_SA(0, 1), a2 + hstep, voffA);
            PG8_WAIT_L(8); PG8_BAR; PG8_WAIT_L(0); PG8_MMA(0, 0, At, B0); PG8_BAR; PG8_SCHED;
            PG8_LDB(B1, 1, 1); PG8_STAGE(PG8_SB(1, 0), b3, voffB);
            PG8_BAR; PG8_WAIT_L(0); PG8_MMA(0, 1, At, B1); PG8_BAR;
            PG8_LDA(At, 1, 1); PG8_STAGE(PG8_SA(1, 0), a3, voffA);
            PG8_BAR; PG8_WAIT_L(0); PG8_MMA(1, 0, At, B0); PG8_BAR; PG8_SCHED;
            PG8_STAGE(PG8_SB(1, 1), b3 + hstep, voffB);
            PG8_WAIT_V(6); PG8_BAR; PG8_MMA(1, 1, At, B1); PG8_BAR;
        }
        if constexpr (!Epi::AFTER_DRAIN) E(acc, cur, wr, wc, fr, fq, pre);
        if (!has_next) break;
#pragma unroll
        for (int a = 0; a < 2; ++a)
#pragma unroll
            for (int b = 0; b < 2; ++b)
#pragma unroll
                for (int m = 0; m < 4; ++m)
#pragma unroll
                    for (int n = 0; n < 2; ++n) acc[a][b][m][n] = (f32x4){0.f, 0.f, 0.f, 0.f};
        cur = nxt; cA = nA; cB = nB; ++ui;
        if constexpr (Epi::PRELOAD) E.preload(cur, wr, fr, pre);
    }
    u32x4 xpre[16];
    if constexpr (Epi::AFTER_DRAIN) E.prefetch(cur, wr, wc, fr, fq, xpre);
    PG8_WAIT_V(0);
    if (wr == 0) PG8_BAR;
    PG8_BAR;
    if constexpr (Epi::AFTER_DRAIN) E.fused(acc, cur, wr, wc, fr, fq, lds, xpre);
#undef PG8_SA
#undef PG8_SB
#undef PG8_STAGE
#undef PG8_LDA
#undef PG8_LDB
#undef PG8_MMA
#undef PG8_WAIT_V
#undef PG8_WAIT_L
#undef PG8_BAR
#undef PG8_SCHED
}
}

struct EpiProj {
    static constexpr bool PERM = true, AFTER_DRAIN = false, PRELOAD = true;
    u16* O; const float* rs;
    DI void preload(const pg8::Unit& u, int wr, int fr, float (&pre)[8]) const {
        const int row0 = u.pm * 256 + wr * 64 + fr;
#pragma unroll
        for (int ai = 0; ai < 2; ++ai)
#pragma unroll
            for (int m = 0; m < 4; ++m) pre[ai * 4 + m] = rs[row0 + ai * 128 + m * 16];
    }
    DI void operator()(const f32x4 (&acc)[2][2][4][2], const pg8::Unit& u, int wr, int wc, int fr, int fq, const float (&pre)[8]) const {
        const int gc = (u.pn == 3) ? 512 : (u.pn == 5) ? 1024 : u.pn * 256, gw = (u.pn >= 2 && u.pn <= 5) ? 512 : 256;
        const size_t gbase = (size_t)NTOK * gc;
        const int row0 = u.pm * 256 + wr * 64 + fr, col0 = u.pn * 256 - gc + wc * 32 + 8 * fq;
#pragma unroll
        for (int ai = 0; ai < 2; ++ai)
#pragma unroll
            for (int m = 0; m < 4; ++m) { const int row = row0 + ai * 128 + m * 16; const float s = pre[ai * 4 + m]; u16* rowp = O + gbase + (size_t)row * gw + col0;
#pragma unroll
                for (int bj = 0; bj < 2; ++bj) { const f32x4 v0 = acc[ai][bj][m][0] * s, v1 = acc[ai][bj][m][1] * s;
                    u32x4 w; w.x = pk2(v0[0], v0[1]); w.y = pk2(v0[2], v0[3]); w.z = pk2(v1[0], v1[1]); w.w = pk2(v1[2], v1[3]);
                    *(u32x4*)(rowp + bj * 128) = w; } }
    }
};
struct EpiOutNorm {
    static constexpr bool PERM = true, AFTER_DRAIN = true, PRELOAD = false;
    const u16* xb; float* out; const float* g; float* slots; unsigned* cnt; unsigned* tmo; int rowbase, panelbase;
    DI void operator()(const f32x4 (&)[2][2][4][2], const pg8::Unit&, int, int, int, int, const float (&)[8]) const {}
    DI void prefetch(const pg8::Unit& u, int wr, int wc, int fr, int fq, u32x4 (&xpre)[16]) const {
        const u16* xr = xb + ((size_t)rowbase + (size_t)u.pm * 256 + wr * 64 + fr) * DM + u.pn * 256 + wc * 32 + 8 * fq;
#pragma unroll
        for (int ai = 0; ai < 2; ++ai)
#pragma unroll
            for (int m = 0; m < 4; ++m) { xpre[(ai * 4 + m) * 2] = *(const u32x4*)(xr + (size_t)(ai * 128 + m * 16) * DM); xpre[(ai * 4 + m) * 2 + 1] = *(const u32x4*)(xr + (size_t)(ai * 128 + m * 16) * DM + 128); }
    }
    DI void fused(f32x4 (&acc)[2][2][4][2], const pg8::Unit& u, int wr, int wc, int fr, int fq, LAS unsigned char* lds, const u32x4 (&xpre)[16]) const {
        int tid_l = threadIdx.x; asm volatile("" : "+v"(tid_l)); const int tid = tid_l;
        LAS float* P = (LAS float*)lds;
        LAS float* R = (LAS float*)(lds + 4096);
        const int trow0 = wr * 64 + fr, col0 = u.pn * 256 + wc * 32 + 8 * fq, pmg = panelbase + u.pm;
        const size_t grow0 = (size_t)rowbase + (size_t)u.pm * 256;
#pragma unroll
        for (int ai = 0; ai < 2; ++ai)
#pragma unroll
            for (int m = 0; m < 4; ++m) { const int trow = trow0 + ai * 128 + m * 16; const u16* xr = xb + (grow0 + trow) * DM + col0; float ss = 0.f;
#pragma unroll
                for (int bj = 0; bj < 2; ++bj) { const u32x4 xv = xpre[(ai * 4 + m) * 2 + bj];
                    f32x4 v0 = acc[ai][bj][m][0], v1 = acc[ai][bj][m][1];
                    v0[0] += lo16(xv.x); v0[1] += hi16(xv.x); v0[2] += lo16(xv.y); v0[3] += hi16(xv.y); v1[0] += lo16(xv.z); v1[1] += hi16(xv.z); v1[2] += lo16(xv.w); v1[3] += hi16(xv.w);
                    acc[ai][bj][m][0] = v0; acc[ai][bj][m][1] = v1;
                    ss += v0[0] * v0[0] + v0[1] * v0[1] + v0[2] * v0[2] + v0[3] * v0[3] + v1[0] * v1[0] + v1[1] * v1[1] + v1[2] * v1[2] + v1[3] * v1[3]; }
                ss += shx(ss, 16); ss += shx(ss, 32);
                if (fq == 0) P[trow * 4 + wc] = ss; }
        __syncthreads();
        if (tid < 256) {
            const f32x4 p4 = *(const LAS f32x4*)(P + tid * 4);
            __hip_atomic_store(slots + (size_t)(pmg * 4 + u.pn) * 256 + tid, p4[0] + p4[1] + p4[2] + p4[3], __ATOMIC_RELAXED, __HIP_MEMORY_SCOPE_AGENT);
            asm volatile("s_waitcnt vmcnt(0)" ::: "memory");
            if ((tid & 63) == 0) __hip_atomic_fetch_add(cnt + pmg * 64, 1u, __ATOMIC_RELAXED, __HIP_MEMORY_SCOPE_AGENT);
        }
        if (tid < 64) {
            if (tid == 0) { unsigned sp = 0;
                while (__hip_atomic_load(cnt + pmg * 64, __ATOMIC_RELAXED, __HIP_MEMORY_SCOPE_AGENT) < 16u) { __builtin_amdgcn_s_sleep(1);
                    if ((++sp & 255u) == 0u) { if (__hip_atomic_load(tmo, __ATOMIC_RELAXED, __HIP_MEMORY_SCOPE_AGENT)) break; if (sp > (1u << 20)) { atomicAdd(tmo, 1u); break; } } } }
            __builtin_amdgcn_fence(__ATOMIC_ACQUIRE, "agent");
            asm volatile("s_waitcnt vmcnt(0)" ::: "memory");
        }
        __syncthreads();
        if (tid < 256) { float tot = 0.f;
#pragma unroll
            for (int j = 0; j < 4; ++j) tot += __hip_atomic_load(slots + (size_t)(pmg * 4 + j) * 256 + tid, __ATOMIC_RELAXED, __HIP_MEMORY_SCOPE_AGENT);
            R[tid] = rsqrtf(tot * (1.f / 1024.f) + EPS); }
        __syncthreads();
        f32x4 gv[2][2];
#pragma unroll
        for (int bj = 0; bj < 2; ++bj)
#pragma unroll
            for (int n = 0; n < 2; ++n) gv[bj][n] = *(const f32x4*)(g + col0 + bj * 128 + n * 4);
#pragma unroll
        for (int ai = 0; ai < 2; ++ai)
#pragma unroll
            for (int m = 0; m < 4; ++m) { const int trow = trow0 + ai * 128 + m * 16; const float rn = R[trow]; float* orow = out + (grow0 + trow) * DM + col0;
#pragma unroll
                for (int bj = 0; bj < 2; ++bj)
#pragma unroll
                    for (int n = 0; n < 2; ++n) *(f32x4*)(orow + bj * 128 + n * 4) = acc[ai][bj][m][n] * rn * gv[bj][n]; }
        __syncthreads();
    }
};

DI void phase_prep(const Ctx& c, LAS unsigned char* lds, int part) {
    int tid_l = threadIdx.x; asm volatile("" : "+v"(tid_l)); const int tid = tid_l, wave = tid >> 6, lane = tid & 63, fr = lane & 15, fq = lane >> 4;
    LAS u16* WgT = (LAS u16*)lds;
    LAS u16* tl = (LAS u16*)(lds + 40960);
    if (part == 0) {
    for (int i = tid; i < 16384; i += 512) { const int k = i >> 4, n = i & 15; WgT[n * 1032 + k] = f2bf(c.w_in[(size_t)k * DIN + 1024 + n] * c.norm_g[k]); }
    __syncthreads();
    for (int grp = blockIdx.x * 8 + wave; grp < NTOK / 16; grp += gridDim.x * 8) {
        const int row0 = grp * 16;
        const float* xr = c.x + (size_t)(row0 + fr) * DM + fq * 8; u16* hr = c.Hb + (size_t)(row0 + fr) * DM + fq * 8;
        f32x4 acc = {0.f, 0.f, 0.f, 0.f}; float ss = 0.f;
#pragma unroll 4
        for (int st = 0; st < 32; ++st) {
            const f32x4 x0 = __builtin_nontemporal_load((const f32x4*)(xr + st * 32)), x1 = __builtin_nontemporal_load((const f32x4*)(xr + st * 32 + 4));
            ss += x0[0] * x0[0] + x0[1] * x0[1] + x0[2] * x0[2] + x0[3] * x0[3] + x1[0] * x1[0] + x1[1] * x1[1] + x1[2] * x1[2] + x1[3] * x1[3];
            u32x4 w; w.x = pk2(x0[0], x0[1]); w.y = pk2(x0[2], x0[3]); w.z = pk2(x1[0], x1[1]); w.w = pk2(x1[2], x1[3]);
            *(u32x4*)(hr + st * 32) = w;
            const bf16x8 bfr = *(const LAS bf16x8*)(WgT + fr * 1032 + st * 32 + fq * 8);
            acc = mfma16(__builtin_bit_cast(bf16x8, w), bfr, acc);
        }
        ss += shx(ss, 16); ss += shx(ss, 32);
        const float rsv = rsqrtf(ss * (1.f / 1024.f) + EPS);
        if (fq == 0) c.rs[row0 + fr] = rsv;
#pragma unroll
        for (int j = 0; j < 4; ++j) { const float rsj = __shfl(rsv, 4 * fq + j); c.gklr[(size_t)(row0 + 4 * fq + j) * 16 + fr] = acc[j] * rsj; }
    }
    }
    if (part == 1)
    for (int tile = blockIdx.x; tile < 256; tile += gridDim.x) {
        const int row0 = (tile >> 4) * 64 + (wave & 3) * 16, col0 = (tile & 15) * 32 + (wave >> 2) * 16;
        const float* mr = c.mem + (size_t)(row0 + fr) * DM + fq * 8;
        f32x4 acc = {0.f, 0.f, 0.f, 0.f}; float ss = 0.f;
#pragma unroll 8
        for (int st = 0; st < 32; ++st) {
            const f32x4 x0 = *(const f32x4*)(mr + st * 32), x1 = *(const f32x4*)(mr + st * 32 + 4);
            const f32x4 g0 = *(const f32x4*)(c.mem_norm_g + st * 32 + fq * 8), g1 = *(const f32x4*)(c.mem_norm_g + st * 32 + fq * 8 + 4);
            ss += x0[0] * x0[0] + x0[1] * x0[1] + x0[2] * x0[2] + x0[3] * x0[3] + x1[0] * x1[0] + x1[1] * x1[1] + x1[2] * x1[2] + x1[3] * x1[3];
            u32x4 w; w.x = pk2(x0[0] * g0[0], x0[1] * g0[1]); w.y = pk2(x0[2] * g0[2], x0[3] * g0[3]); w.z = pk2(x1[0] * g1[0], x1[1] * g1[1]); w.w = pk2(x1[2] * g1[2], x1[3] * g1[3]);
            const float* wp = c.w_mem_kv + (size_t)(st * 32 + fq * 8) * 512 + col0 + fr;
            u32x4 bw; bw.x = pk2(wp[0], wp[512]); bw.y = pk2(wp[1024], wp[1536]); bw.z = pk2(wp[2048], wp[2560]); bw.w = pk2(wp[3072], wp[3584]);
            acc = mfma16(__builtin_bit_cast(bf16x8, w), __builtin_bit_cast(bf16x8, bw), acc);
        }
        ss += shx(ss, 16); ss += shx(ss, 32);
        const float rsv = rsqrtf(ss * (1.f / 1024.f) + EPS);
#pragma unroll
        for (int j = 0; j < 4; ++j) { const float rsj = __shfl(rsv, 4 * fq + j); c.kv[(size_t)(row0 + 4 * fq + j) * 512 + col0 + fr] = f2bf(acc[j] * rsj); }
    }
    if (part != 1)
    for (int tile = (part == 0 ? 0 : 640) + blockIdx.x; tile < (part == 0 ? 640 : 896); tile += gridDim.x) {
        const float* src; int ld; u16* dst;
        if (tile < 640) { const int kt = tile / 40, ntl = tile % 40, n0 = ntl * 64, sc = n0 < 1024 ? n0 : n0 + 16; src = c.w_in + (size_t)(kt * 64) * DIN + sc; ld = DIN; dst = c.WiT + (size_t)n0 * 1024 + kt * 64; }
        else { const int t2 = tile - 640, kt = t2 >> 4, ntl = t2 & 15; src = c.w_out + (size_t)(kt * 64) * 1024 + ntl * 64; ld = 1024; dst = c.WoT + (size_t)(ntl * 64) * 1024 + kt * 64; }
#pragma unroll
        for (int i = 0; i < 2; ++i) { const int kk = (tid >> 4) + 32 * i, nn = (tid & 15) * 4; const float gk = tile < 640 ? c.norm_g[(tile / 40) * 64 + kk] : 1.f; const f32x4 v = *(const f32x4*)(src + (size_t)kk * ld + nn) * gk;
            tl[(nn + 0) * 72 + kk] = f2bf(v[0]); tl[(nn + 1) * 72 + kk] = f2bf(v[1]); tl[(nn + 2) * 72 + kk] = f2bf(v[2]); tl[(nn + 3) * 72 + kk] = f2bf(v[3]); }
        __syncthreads();
        { const int n = tid >> 3, kc = (tid & 7) * 8; *(u32x4*)(dst + (size_t)n * 1024 + kc) = *(const LAS u32x4*)(tl + n * 72 + kc); }
        __syncthreads();
    }
}

constexpr int VS_STRIDE = 528, VS_BYTES = 64 * VS_STRIDE * 2;
DI void phase_gla_cs(const Ctx& c, LAS unsigned char* lds) {
    int tid_l = threadIdx.x; asm volatile("" : "+v"(tid_l)); const int tid = tid_l, wave = tid >> 6, lane = tid & 63, hs = lane >> 5, r = lane & 31;
    LAS u16* Vs = (LAS u16*)lds;
    LAS u16* Kk = (LAS u16*)(lds + VS_BYTES);
    LAS u16* kdT = (LAS u16*)(lds + VS_BYTES + 32768);
    LAS float* decS = (LAS float*)(lds + VS_BYTES + 32768 + 36864);
    LAS float* totS = decS + 256;
    u32x4 pre[12];
    int item = blockIdx.x;
    if (item < 512) {
        const int tok0 = (item >> 7) * SEQ + (item & 127) * 64;
#pragma unroll
        for (int i = 0; i < 8; ++i) { const int id = tid + 512 * i; pre[i] = *(const u32x4*)(c.proj + PB_V + (size_t)(tok0 + (id >> 6)) * 512 + (id & 63) * 8); }
#pragma unroll
        for (int i = 0; i < 4; ++i) { const int id = tid + 512 * i; pre[8 + i] = *(const u32x4*)(c.proj + PB_K + (size_t)(tok0 + (id >> 5)) * 256 + (id & 31) * 8); }
    }
    for (; item < 512; item += gridDim.x) {
        const int b = item >> 7, n = item & 127, tok0 = b * SEQ + n * 64;
        const int h = wave >> 1, half = wave & 1, d = lane;
#pragma unroll
        for (int i = 0; i < 8; ++i) { const int id = tid + 512 * i; *(LAS u32x4*)(Vs + (id >> 6) * VS_STRIDE + (id & 63) * 8) = pre[i]; }
#pragma unroll
        for (int i = 0; i < 4; ++i) { const int id = tid + 512 * i; *(LAS u32x4*)(Kk + (id >> 5) * 256 + (id & 31) * 8) = pre[8 + i]; }
        float lr[16], wup[16];
        { const f32x4* p = (const f32x4*)(c.gklr + (size_t)(tok0 + lane) * 16);
#pragma unroll
          for (int q = 0; q < 4; ++q) { const f32x4 v = p[q]; lr[4 * q] = v[0]; lr[4 * q + 1] = v[1]; lr[4 * q + 2] = v[2]; lr[4 * q + 3] = v[3]; } }
#pragma unroll
        for (int q = 0; q < 16; ++q) wup[q] = c.w_gk_up[q * 256 + h * 64 + d];
        const float bg = c.b_gk[h * 64 + d];
        { const int nx = item + gridDim.x;
          if (nx < 512) { const int t0n = (nx >> 7) * SEQ + (nx & 127) * 64;
#pragma unroll
            for (int i = 0; i < 8; ++i) { const int id = tid + 512 * i; pre[i] = *(const u32x4*)(c.proj + PB_V + (size_t)(t0n + (id >> 6)) * 512 + (id & 63) * 8); }
#pragma unroll
            for (int i = 0; i < 4; ++i) { const int id = tid + 512 * i; pre[8 + i] = *(const u32x4*)(c.proj + PB_K + (size_t)(t0n + (id >> 5)) * 256 + (id & 31) * 8); } } }
        float bl[32]; float bsum = 0.f;
#pragma unroll
        for (int j = 0; j < 32; ++j) {
            float logit = bg;
#pragma unroll
            for (int q = 0; q < 16; ++q) logit = fmaf(__int_as_float(__builtin_amdgcn_readlane(__float_as_int(lr[q]), half * 32 + j)), wup[q], logit);
            const float ls = fminf(logit, 0.f) - __logf(1.f + __expf(-fabsf(logit)));
            bsum += ls * 0.0625f; bl[j] = bsum;
        }
        if (half == 0) totS[h * 64 + d] = bsum;
        __syncthreads();
        {
            const float off = half ? totS[h * 64 + d] : 0.f;
            u16* bp = c.bcum + (size_t)(tok0 + half * 32) * 256 + h * 64 + d;
            LAS u16* kd = kdT + h * 4608 + d * 72 + half * 32;
            const LAS u16* kk = Kk + half * 32 * 256 + h * 64 + d;
#pragma unroll
            for (int j = 0; j < 32; ++j) { const float bb = off + bl[j]; bp[(size_t)j * 256] = __builtin_bit_cast(u16, (_Float16)bb); kd[j] = f2bf(bf2f(kk[j * 256]) * __expf(-bb)); }
            if (half) { const float dec = __expf(off + bsum); c.dec[(size_t)((b * 4 + h) * 128 + n) * 64 + d] = dec; decS[h * 64 + d] = dec; }
        }
        __syncthreads();
        {
            const int mp = half;
            bf16x8 fb[2][4];
#pragma unroll
            for (int nt = 0; nt < 2; ++nt)
#pragma unroll
                for (int s = 0; s < 4; ++s) fb[nt][s] = *(const LAS bf16x8*)(kdT + h * 4608 + (nt * 32 + r) * 72 + 16 * s + 8 * hs);
            const float dec0 = decS[h * 64 + r], dec1 = decS[h * 64 + 32 + r];
            u16* cso = c.cs + (size_t)((b * 4 + h) * 128 + n) * 8192;
#pragma unroll
            for (int mi = 0; mi < 2; ++mi) {
                const int mt = mp * 2 + mi;
                f32x16 a0 = zero16(), a1 = zero16();
#pragma unroll
                for (int s = 0; s < 4; ++s) {
                    const bf16x8 av = tr_frag(Vs, VS_STRIDE, 16 * s + 8 * hs, 16 * s + 8 * hs + 4, h * 128 + mt * 32, lane);
                    a0 = mfma32(av, fb[0][s], a0); a1 = mfma32(av, fb[1][s], a1);
                }
#pragma unroll
                for (int i = 0; i < 16; ++i) { const int e = mt * 32 + crow(i, hs); cso[e * 64 + r] = f2bf(a0[i] * dec0); cso[e * 64 + 32 + r] = f2bf(a1[i] * dec1); }
            }
        }
        __syncthreads();
    }
}

DI void phase_scan(const Ctx& c, LAS unsigned char* lds) {
    int tid_l = threadIdx.x; asm volatile("" : "+v"(tid_l)); const int tid = tid_l;
    LAS float* decL = (LAS float*)lds;
    for (int blk = blockIdx.x; blk < 256; blk += gridDim.x) {
        const int bh = blk >> 4, idx = ((blk & 15) * 256 + (tid & 255)) * 2, d = idx & 63;
#pragma unroll
        for (int i = 0; i < 4; ++i) { const int id = tid + 512 * i; *(LAS f32x4*)(decL + id * 4) = *(const f32x4*)(c.dec + (size_t)bh * 8192 + id * 4); }
        unsigned* p = (unsigned*)(c.cs + (size_t)bh * 128 * 8192 + idx);
        unsigned cv[128];
        if (tid < 256) {
#pragma unroll
            for (int n = 0; n < 128; ++n) cv[n] = p[(size_t)n * 4096];
        }
        __syncthreads();
        if (tid < 256) {
            float S0 = 0.f, S1 = 0.f;
#pragma unroll
            for (int n = 0; n < 128; ++n) { const f32x2 dc = *(const LAS f32x2*)(decL + n * 64 + d); p[(size_t)n * 4096] = pk2(S0, S1); S0 = fmaf(dc[0], S0, lo16(cv[n])); S1 = fmaf(dc[1], S1, hi16(cv[n])); }
        }
        __syncthreads();
    }
}

template <int W> DI void pool_item(const Ctx& c, int g, int span0, int lane) {
    const int hs = lane >> 5, r = lane & 31;
    const int pos0 = span0 & (SEQ - 1);
#pragma unroll 1
    for (int nt = 0; nt < 2; ++nt) {
        bf16x8 fb[4];
#pragma unroll
        for (int s = 0; s < 4; ++s) { const float* wp = c.pool_w + (size_t)(g * 64 + 16 * s + 8 * hs) * 64 + nt * 32 + r;
            u32x4 w; w.x = pk2(wp[0], wp[64]); w.y = pk2(wp[128], wp[192]); w.z = pk2(wp[256], wp[320]); w.w = pk2(wp[384], wp[448]); fb[s] = __builtin_bit_cast(bf16x8, w); }
        const float ps = c.pool_scale[g * 64 + nt * 32 + r];
        float prev[16];
#pragma unroll
        for (int i = 0; i < 16; ++i) prev[i] = 0.f;
#pragma unroll 1
        for (int tt = (pos0 == 0 ? 0 : -1); tt < 2; ++tt) {
            const int tok0 = span0 + tt * 32;
            f32x16 z = zero16();
#pragma unroll
            for (int s = 0; s < 4; ++s) z = mfma32(*(const bf16x8*)(c.proj + PB_UP + (size_t)(tok0 + r) * 256 + g * 64 + 16 * s + 8 * hs), fb[s], z);
            float full[32];
#pragma unroll
            for (int i = 0; i < 16; ++i) { const float o = shx(z[i], 32); full[crow(i, 0)] = hs ? o : z[i]; full[crow(i, 1)] = hs ? z[i] : o; }
            if (tt >= 0) {
                float P[48];
                P[0] = prev[0];
#pragma unroll
                for (int k = 1; k < 16; ++k) P[k] = P[k - 1] + prev[k];
#pragma unroll
                for (int k = 0; k < 32; ++k) P[16 + k] = P[15 + k] + full[k];
#pragma unroll
                for (int i = 0; i < 16; ++i) {
                    const int t0 = crow(i, 0), t1 = crow(i, 1), t = hs ? t1 : t0;
                    const float ws = hs ? (P[t1 + 16] - P[t1 + 16 - W]) : (P[t0 + 16] - P[t0 + 16 - W]);
                    const int pos = pos0 + tt * 32 + t;
                    const float cinv = 1.f / (float)(pos + 1 < W ? pos + 1 : W);
                    const float val = ws * cinv - z[i];
                    const size_t tok = (size_t)(tok0 + t);
                    const float gate = bf2f(c.proj[PB_GP + tok * 256 + g * 64 + nt * 32 + r]);
                    c.mixed[tok * DM + 512 + g * 64 + nt * 32 + r] = f2bf(val * ps * silu(gate));
                }
            }
#pragma unroll
            for (int k = 0; k < 16; ++k) prev[k] = full[16 + k];
        }
    }
}
DI void phase_pool(const Ctx& c) {
    int tid_l = threadIdx.x; asm volatile("" : "+v"(tid_l)); const int tid = tid_l, wave = tid >> 6, lane = tid & 63;
    for (int gw = blockIdx.x * 8 + wave; gw < 2048; gw += gridDim.x * 8) {
        const int g = gw & 3, span0 = (gw >> 2) * 64;
        if (g == 0) pool_item<2>(c, 0, span0, lane); else if (g == 1) pool_item<4>(c, 1, span0, lane); else if (g == 2) pool_item<8>(c, 2, span0, lane); else pool_item<16>(c, 3, span0, lane);
    }
}

DI void phase_memattn(const Ctx& c, LAS unsigned char* lds) {
    int tid_l = threadIdx.x; asm volatile("" : "+v"(tid_l)); const int tid = tid_l, wave = tid >> 6, lane = tid & 63, hs = lane >> 5, r = lane & 31;
    LAS u16* Ks = (LAS u16*)lds;
    LAS u16* Vt = (LAS u16*)(lds + 256 * 72 * 2);
    for (int unit = blockIdx.x; unit < 256; unit += gridDim.x) {
        const int b = unit >> 6, hm = (unit >> 4) & 3, tokbase = b * SEQ + (unit & 15) * 512;
        bf16x8 qf[2][4]; u32x4 gv[2][4];
#pragma unroll
        for (int ti = 0; ti < 2; ++ti) { const size_t tok = (size_t)(tokbase + (wave * 2 + ti) * 32 + r);
#pragma unroll
            for (int s = 0; s < 4; ++s) qf[ti][s] = *(const bf16x8*)(c.proj + PB_QM + tok * 256 + hm * 64 + 16 * s + 8 * hs);
#pragma unroll
            for (int g8 = 0; g8 < 4; ++g8) gv[ti][g8] = *(const u32x4*)(c.proj + PB_GM + tok * 256 + hm * 64 + 16 * g8 + 8 * hs); }
        { const int row = tid >> 1, half = tid & 1; const u16* src = c.kv + (size_t)(b * 256 + row) * 512 + hm * 64 + half * 32;
#pragma unroll
          for (int q = 0; q < 4; ++q) *(LAS u32x4*)(Ks + row * 72 + half * 32 + q * 8) = *(const u32x4*)(src + q * 8); }
        { const int m = tid & 255, dvh = tid >> 8; const u16* src = c.kv + (size_t)(b * 256 + m) * 512 + 256 + hm * 64 + dvh * 32;
#pragma unroll
          for (int q = 0; q < 4; ++q) { const u32x4 v = *(const u32x4*)(src + q * 8);
#pragma unroll
              for (int j = 0; j < 4; ++j) { Vt[(dvh * 32 + q * 8 + 2 * j) * 260 + m] = (u16)(v[j] & 0xffffu); Vt[(dvh * 32 + q * 8 + 2 * j + 1) * 260 + m] = (u16)(v[j] >> 16); } } }
        __syncthreads();
#pragma unroll
        for (int ti = 0; ti < 2; ++ti) {
            const int tok = tokbase + (wave * 2 + ti) * 32 + r;
            float mrun = -3.0e38f, lsum = 0.f;
            f32x16 O0 = zero16(), O1 = zero16();
#pragma unroll 1
            for (int hf = 0; hf < 2; ++hf) {
                f32x16 X[4];
#pragma unroll
                for (int mq = 0; mq < 4; ++mq) { X[mq] = zero16();
#pragma unroll
                    for (int s = 0; s < 4; ++s) X[mq] = mfma32(*(const LAS bf16x8*)(Ks + ((hf * 4 + mq) * 32 + r) * 72 + 16 * s + 8 * hs), qf[ti][s], X[mq]); }
                float mx = -3.0e38f;
#pragma unroll
                for (int mq = 0; mq < 4; ++mq)
#pragma unroll
                    for (int i = 0; i < 16; ++i) mx = fmaxf(mx, X[mq][i]);
                mx = fmaxf(mx, shx(mx, 32));
                const float mnew = fmaxf(mrun, mx), alpha = exp2f((mrun - mnew) * 0.18033688f);
                mrun = mnew; lsum *= alpha;
#pragma unroll
                for (int i = 0; i < 16; ++i) { O0[i] *= alpha; O1[i] *= alpha; }
#pragma unroll
                for (int mq = 0; mq < 4; ++mq)
#pragma unroll
                    for (int i = 0; i < 16; ++i) { const float p = exp2f((X[mq][i] - mnew) * 0.18033688f); X[mq][i] = p; lsum += p; }
#pragma unroll
                for (int mq = 0; mq < 4; ++mq)
#pragma unroll
                    for (int s2 = 0; s2 < 2; ++s2) {
                        u32x4 pb; pb.x = pk2(X[mq][8 * s2], X[mq][8 * s2 + 1]); pb.y = pk2(X[mq][8 * s2 + 2], X[mq][8 * s2 + 3]); pb.z = pk2(X[mq][8 * s2 + 4], X[mq][8 * s2 + 5]); pb.w = pk2(X[mq][8 * s2 + 6], X[mq][8 * s2 + 7]);
                        const int mo = (hf * 4 + mq) * 32 + 16 * s2 + 4 * hs;
                        const u32x2 a00 = *(const LAS u32x2*)(Vt + r * 260 + mo), a01 = *(const LAS u32x2*)(Vt + r * 260 + mo + 8);
                        const u32x2 a10 = *(const LAS u32x2*)(Vt + (32 + r) * 260 + mo), a11 = *(const LAS u32x2*)(Vt + (32 + r) * 260 + mo + 8);
                        const u32x4 A0 = {a00.x, a00.y, a01.x, a01.y}, A1 = {a10.x, a10.y, a11.x, a11.y};
                        O0 = mfma32(__builtin_bit_cast(bf16x8, A0), __builtin_bit_cast(bf16x8, pb), O0);
                        O1 = mfma32(__builtin_bit_cast(bf16x8, A1), __builtin_bit_cast(bf16x8, pb), O1);
                    }
            }
            lsum += shx(lsum, 32);
            const float inv = 1.f / lsum;
            u16* mp = c.mixed + (size_t)tok * DM + 768 + hm * 64;
#pragma unroll
            for (int dvt = 0; dvt < 2; ++dvt)
#pragma unroll
                for (int jp = 0; jp < 2; ++jp) {
                    const u32x4 gq = gv[ti][dvt * 2 + jp];
                    unsigned ga[2] = {gq.x, gq.z}, gb[2] = {gq.y, gq.w};
                    swap32(ga[0], ga[1]); swap32(gb[0], gb[1]);
                    unsigned wx[2], wy[2];
#pragma unroll
                    for (int k = 0; k < 2; ++k) { const int g4 = 2 * jp + k;
                        const float o0 = dvt ? O1[4 * g4] : O0[4 * g4], o1 = dvt ? O1[4 * g4 + 1] : O0[4 * g4 + 1], o2 = dvt ? O1[4 * g4 + 2] : O0[4 * g4 + 2], o3 = dvt ? O1[4 * g4 + 3] : O0[4 * g4 + 3];
                        wx[k] = pk2(o0 * inv * silu(lo16(ga[k])), o1 * inv * silu(hi16(ga[k]))); wy[k] = pk2(o2 * inv * silu(lo16(gb[k])), o3 * inv * silu(hi16(gb[k]))); }
                    swap32(wx[0], wx[1]); swap32(wy[0], wy[1]);
                    const u32x4 o = {wx[0], wy[0], wx[1], wy[1]};
                    *(u32x4*)(mp + dvt * 32 + 16 * jp + 8 * hs) = o; }
        }
        __syncthreads();
    }
}

DI void gla_frags(const Ctx& c, size_t row, int c8, bf16x8 (&qd)[4], bf16x8 (&kd)[4], int hs) {
#pragma unroll
    for (int s = 0; s < 4; ++s) {
        const int cc = c8 + 16 * s + 8 * hs;
        const u32x4 qv = *(const u32x4*)(c.proj + PB_Q + row * 256 + cc), kv = *(const u32x4*)(c.proj + PB_K + row * 256 + cc);
        const f32x8 bb = __builtin_convertvector(*(const h16x8*)(c.bcum + row * 256 + cc), f32x8);
        u32x4 qo, ko;
#pragma unroll
        for (int q = 0; q < 4; ++q) { const float e0 = __expf(bb[2 * q]), e1 = __expf(bb[2 * q + 1]);
            qo[q] = pk2(lo16(qv[q]) * 0.125f * e0, hi16(qv[q]) * 0.125f * e1);
            ko[q] = pk2(lo16(kv[q]) * __expf(-bb[2 * q]), hi16(kv[q]) * __expf(-bb[2 * q + 1])); }
        qd[s] = __builtin_bit_cast(bf16x8, qo); kd[s] = __builtin_bit_cast(bf16x8, ko);
    }
}
DI void pack_x(const f32x16& X, u32x4 (&pb)[2]) {
#pragma unroll
    for (int s2 = 0; s2 < 2; ++s2) { pb[s2].x = pk2(X[8 * s2], X[8 * s2 + 1]); pb[s2].y = pk2(X[8 * s2 + 2], X[8 * s2 + 3]); pb[s2].z = pk2(X[8 * s2 + 4], X[8 * s2 + 5]); pb[s2].w = pk2(X[8 * s2 + 6], X[8 * s2 + 7]); }
}
DI void phase_gla_out(const Ctx& c, LAS unsigned char* lds, int item0, int item1) {
    int tid_l = threadIdx.x; asm volatile("" : "+v"(tid_l)); const int tid = tid_l, wave = tid >> 6, lane = tid & 63, hs = lane >> 5, r = lane & 31;
    LAS u16* Vs = (LAS u16*)lds;
    LAS u16* Ss = (LAS u16*)(lds + VS_BYTES);
    for (int item = item0; item < item1; item += gridDim.x) {
        const int b = item >> 7, n = item & 127, tok0 = b * SEQ + n * 64;
        const int h = wave >> 1, it = wave & 1;
#pragma unroll
        for (int i = 0; i < 8; ++i) { const int id = tid + 512 * i, row = id >> 6, cc = id & 63;
            *(LAS u32x4*)(Vs + row * VS_STRIDE + cc * 8) = *(const u32x4*)(c.proj + PB_V + (size_t)(tok0 + row) * 512 + cc * 8); }
#pragma unroll
        for (int i = 0; i < 8; ++i) { const int id = tid + 512 * i, hh = id >> 10, e = (id >> 3) & 127, cc = id & 7;
            *(LAS u32x4*)(Ss + (hh * 128 + e) * 72 + cc * 8) = *(const u32x4*)(c.cs + (size_t)((b * 4 + hh) * 128 + n) * 8192 + e * 64 + cc * 8); }
        bf16x8 qd[4], kdc[4], kd0[4];
        gla_frags(c, (size_t)(tok0 + it * 32 + r), h * 64, qd, kdc, hs);
        if (it == 1) { bf16x8 qx[4]; gla_frags(c, (size_t)(tok0 + r), h * 64, qx, kd0, hs); }
        f32x16 Xd = zero16(), Xo = zero16();
#pragma unroll
        for (int s = 0; s < 4; ++s) Xd = mfma32(kdc[s], qd[s], Xd);
        if (it == 1) {
#pragma unroll
            for (int s = 0; s < 4; ++s) Xo = mfma32(kd0[s], qd[s], Xo);
        }
#pragma unroll
        for (int i = 0; i < 16; ++i) if (crow(i, hs) > r) Xd[i] = 0.f;
        u32x4 pbd[2], pbo[2];
        pack_x(Xd, pbd); pack_x(Xo, pbo);
        const size_t tok = (size_t)(tok0 + it * 32 + r);
        const u16* gp = c.proj + PB_GG + tok * 512 + h * 128; u16* mp = c.mixed + tok * DM + h * 128;
        u32x4 gvq[8];
#pragma unroll
        for (int q = 0; q < 8; ++q) gvq[q] = *(const u32x4*)(gp + 16 * q + 8 * hs);
        __syncthreads();
        f32x16 O[4];
#pragma unroll
        for (int mt = 0; mt < 4; ++mt) {
            O[mt] = zero16();
#pragma unroll
            for (int s2 = 0; s2 < 2; ++s2)
                O[mt] = mfma32(tr_frag(Vs, VS_STRIDE, it * 32 + 16 * s2 + 4 * hs, it * 32 + 16 * s2 + 8 + 4 * hs, h * 128 + mt * 32, lane), __builtin_bit_cast(bf16x8, pbd[s2]), O[mt]);
            if (it == 1) {
#pragma unroll
                for (int s2 = 0; s2 < 2; ++s2)
                    O[mt] = mfma32(tr_frag(Vs, VS_STRIDE, 16 * s2 + 4 * hs, 16 * s2 + 8 + 4 * hs, h * 128 + mt * 32, lane), __builtin_bit_cast(bf16x8, pbo[s2]), O[mt]);
            }
#pragma unroll
            for (int s = 0; s < 4; ++s) O[mt] = mfma32(*(const LAS bf16x8*)(Ss + (h * 128 + mt * 32 + r) * 72 + 16 * s + 8 * hs), qd[s], O[mt]);
        }
        float ss = 0.f;
#pragma unroll
        for (int mt = 0; mt < 4; ++mt)
#pragma unroll
            for (int i = 0; i < 16; ++i) ss += O[mt][i] * O[mt][i];
        ss += shx(ss, 32);
        const float rn = rsqrtf(ss * (1.f / 128.f) + EPS);
#pragma unroll
        for (int mt = 0; mt < 4; ++mt)
#pragma unroll
            for (int jp = 0; jp < 2; ++jp) {
                const u32x4 gq = gvq[mt * 2 + jp];
                unsigned ga[2] = {gq.x, gq.z}, gb[2] = {gq.y, gq.w};
                swap32(ga[0], ga[1]); swap32(gb[0], gb[1]);
                unsigned wx[2], wy[2];
#pragma unroll
                for (int k = 0; k < 2; ++k) { const int g4 = 2 * jp + k, e0 = mt * 32 + 8 * g4 + 4 * hs; const f32x4 ng = *(const f32x4*)(c.gla_norm_g + e0);
                    wx[k] = pk2(O[mt][4 * g4] * rn * ng[0] * silu(lo16(ga[k])), O[mt][4 * g4 + 1] * rn * ng[1] * silu(hi16(ga[k])));
                    wy[k] = pk2(O[mt][4 * g4 + 2] * rn * ng[2] * silu(lo16(gb[k])), O[mt][4 * g4 + 3] * rn * ng[3] * silu(hi16(gb[k]))); }
                swap32(wx[0], wx[1]); swap32(wy[0], wy[1]);
                const u32x4 o = {wx[0], wy[0], wx[1], wy[1]};
                *(u32x4*)(mp + mt * 32 + 16 * jp + 8 * hs) = o; }
        __syncthreads();
    }
}

#define XB_TMO      128
#define XB_XCNT(j)  (256  + 64 * (j))
#define XB_XSUB(j)  (1280 + 64 * (j))
#define XB_XGEN(j)  (2304 + 64 * (j))
#define XB_TOP      3328
#define XB_TOPGEN   3392
#define XCD_BAR_WORDS 3456
#define XB_SPIN_CAP (1u << 20)
DI unsigned xb_ld(unsigned* p)              { return __hip_atomic_load(p, __ATOMIC_RELAXED, __HIP_MEMORY_SCOPE_AGENT); }
DI unsigned xb_add(unsigned* p, unsigned v) { return __hip_atomic_fetch_add(p, v, __ATOMIC_RELAXED, __HIP_MEMORY_SCOPE_AGENT); }
DI unsigned xb_xcc_id() { return (unsigned)__builtin_amdgcn_s_getreg((3 << 11) | 20) & 0xFu; }
#define XB_SPIN(cond, bar) do { unsigned _sp = 0; while (cond) { __builtin_amdgcn_s_sleep(1); \
    if ((++_sp & 255u) == 0u) { if (xb_ld(&(bar)[XB_TMO])) break; if (_sp > XB_SPIN_CAP) { atomicAdd(&(bar)[XB_TMO], 1u); break; } } } } while (0)
struct XcdBarrier { unsigned* bar; unsigned x; volatile LAS unsigned* st; };
DI XcdBarrier xcd_barrier_post(unsigned* bar, volatile LAS unsigned* st) {
    XcdBarrier b; b.bar = bar; b.x = xb_xcc_id(); b.st = st;
    if (threadIdx.x == 0) (void)xb_add(&bar[XB_XCNT(b.x)], 1u);
    return b;
}
DI void xcd_barrier_complete(unsigned* bar, unsigned x, unsigned& nloc, unsigned& nx) {
    const unsigned G = gridDim.x * gridDim.y * gridDim.z;
    unsigned sum, cnt, mine, sp = 0u;
    for (;;) {
        sum = 0u; cnt = 0u; mine = 0u;
#pragma unroll
        for (unsigned j = 0; j < 16; ++j) { const unsigned cc = xb_ld(&bar[XB_XCNT(j)]); sum += cc; cnt += (cc > 0u) ? 1u : 0u; mine = (j == x) ? cc : mine; }
        if (sum == G) break;
        __builtin_amdgcn_s_sleep(1);
        if ((++sp & 255u) == 0u) { if (xb_ld(&bar[XB_TMO])) break; if (sp > XB_SPIN_CAP) { atomicAdd(&bar[XB_TMO], 1u); break; } }
    }
    nloc = mine > 0u ? mine : 1u; nx = cnt > 0u ? cnt : 1u;
}
DI void xsb_arrive(const XcdBarrier& b) {
    asm volatile("s_waitcnt vmcnt(0)" ::: "memory");
    __syncthreads();
    if (threadIdx.x == 0) {
        unsigned* bar = b.bar;
        unsigned nloc = b.st[0], nx = b.st[1];
        if (nloc == 0u) { xcd_barrier_complete(bar, b.x, nloc, nx); b.st[0] = nloc; b.st[1] = nx; }
        const unsigned old = xb_add(&bar[XB_XSUB(b.x)], 1u);
        const unsigned gen = old / nloc;
        if (old + 1u == (gen + 1u) * nloc) {
            __builtin_amdgcn_fence(__ATOMIC_RELEASE, "agent");
            asm volatile("s_waitcnt vmcnt(0)" ::: "memory");
            (void)xb_add(&bar[XB_TOP], 1u);
        }
    }
}
DI void xsb_wait(const XcdBarrier& b, unsigned round) {
    if (threadIdx.x == 0) {
        unsigned* bar = b.bar;
        const unsigned need = round * b.st[1];
        XB_SPIN(xb_ld(&bar[XB_TOP]) < need, bar);
        __builtin_amdgcn_fence(__ATOMIC_ACQUIRE, "agent");
        asm volatile("s_waitcnt vmcnt(0)" ::: "memory");
    }
    __syncthreads();
}

__global__ void __launch_bounds__(512, 2) hybrid_fwd(Ctx c) {
    extern __shared__ __attribute__((aligned(16))) unsigned char lds_raw[];
    LAS unsigned char* lds = (LAS unsigned char*)lds_raw;
    volatile LAS unsigned* xst = (volatile LAS unsigned*)(lds + 144 * 1024);
    if (threadIdx.x == 0) { xst[0] = 0u; xst[1] = 0u; xst[2] = 0u; xst[3] = 0u; }
    __syncthreads();
    const XcdBarrier xb = xcd_barrier_post(c.bar, xst);
    const XcdBarrier xb2 = xcd_barrier_post(c.bar + XCD_BAR_WORDS + 8192, xst + 2);
    phase_prep(c, lds, 0); __syncthreads();
    xsb_arrive(xb);
    phase_prep(c, lds, 2); __syncthreads();
    xsb_wait(xb, 1u);
    const bool kv_first = ((blockIdx.x >> 3) & 1) != 0;
    if (kv_first) { phase_prep(c, lds, 1); __syncthreads(); }
    { pg8::Gemm g{c.Hb, c.WiT, NTOK, NMAIN, DM}; pg8::StaticOrder S; S.init(NTOK, NMAIN, (int)gridDim.x, (int)blockIdx.x); EpiProj E{c.proj, c.rs}; pg8::gemm_phase<EpiProj>(lds, g, S, E); __syncthreads(); }
    xsb_arrive(xb);
    if (!kv_first) { phase_prep(c, lds, 1); __syncthreads(); }
    xsb_wait(xb, 2u);
    phase_gla_cs(c, lds); __syncthreads();
    xsb_arrive(xb);
    phase_pool(c);
    xsb_wait(xb, 3u);
    phase_scan(c, lds);
    xsb_arrive(xb);
    phase_memattn(c, lds);
    xsb_wait(xb, 4u);
    phase_gla_out(c, lds, (int)blockIdx.x, 256); __syncthreads();
    xsb_arrive(xb);
    phase_gla_out(c, lds, 256 + (int)blockIdx.x, 512); __syncthreads();
    xsb_arrive(xb2);
    xsb_wait(xb, 5u);
    for (int half = 0; half < 2; ++half) {
        if (half == 1) xsb_wait(xb2, 1u);
        pg8::Gemm g{c.mixed + (size_t)half * 16384 * DM, c.WoT, 16384, DM, DM}; pg8::StaticOrder S; S.init(16384, DM, (int)gridDim.x, (int)blockIdx.x);
        EpiOutNorm E{c.Hb, c.out, c.final_g, c.slots, c.bar + XCD_BAR_WORDS, c.bar + XB_TMO, half * 16384, half * 64};
        pg8::gemm_phase<EpiOutNorm>(lds, g, S, E);
    }
}

constexpr size_t LDS_XST = 144 * 1024;
constexpr size_t LDS_BYTES = LDS_XST + 16;
extern "C" void kernel_launch(void* const* d_in, const int* in_sizes, int n_in, void* d_out, int out_size, void* d_ws, size_t ws_size, hipStream_t stream) {
    static int grid_blocks = 0;
    if (!grid_blocks) {
        int dev = 0, cus = 0, per_cu = 0;
        hipGetDevice(&dev);
        hipDeviceGetAttribute(&cus, hipDeviceAttributeMultiprocessorCount, dev);
        hipFuncSetAttribute((const void*)hybrid_fwd, hipFuncAttributeMaxDynamicSharedMemorySize, (int)LDS_BYTES);
        hipOccupancyMaxActiveBlocksPerMultiprocessor(&per_cu, (const void*)hybrid_fwd, 512, LDS_BYTES);
        if (per_cu < 1) { fprintf(stderr, "occupancy query says %d blocks per CU\n", per_cu); per_cu = 1; }
        if (per_cu > 1) per_cu = 1;
        grid_blocks = cus * per_cu;
        if (grid_blocks != 256) fprintf(stderr, "this kernel is built for a 256-CU device (grid %d)\n", grid_blocks);
    }
    Ctx c{};
    c.x = (const float*)d_in[0]; c.mem = (const float*)d_in[1]; c.norm_g = (const float*)d_in[2]; c.w_in = (const float*)d_in[3]; c.w_gk_up = (const float*)d_in[4];
    c.b_gk = (const float*)d_in[5]; c.gla_norm_g = (const float*)d_in[6]; c.pool_w = (const float*)d_in[7]; c.pool_scale = (const float*)d_in[8]; c.mem_norm_g = (const float*)d_in[9];
    c.w_mem_kv = (const float*)d_in[10]; c.w_out = (const float*)d_in[11]; c.final_g = (const float*)d_in[12];
    c.out = (float*)d_out;
    constexpr size_t WS_NEED = (size_t)384 << 20;
    unsigned char* w = (unsigned char*)d_ws + (ws_size > WS_NEED ? ((ws_size - WS_NEED) & ~(size_t)4095) : 0); size_t off = 0;
    auto take = [&](size_t bytes) { unsigned char* p = w + off; off += (bytes + 255) & ~(size_t)255; return p; };
    c.bar = (unsigned*)take((size_t)(2 * XCD_BAR_WORDS + 8192) * 4); c.slots = (float*)take((size_t)128 * 4 * 256 * 4);
    c.rs = (float*)take((size_t)NTOK * 4); c.gklr = (float*)take((size_t)NTOK * 16 * 4); c.dec = (float*)take((size_t)2048 * 64 * 4); c.kv = (u16*)take((size_t)1024 * 512 * 2);
    c.WoT = (u16*)take((size_t)1024 * 1024 * 2);
    c.mixed = (u16*)take((size_t)NTOK * 1024 * 2); c.cs = (u16*)take((size_t)2048 * 8192 * 2); c.bcum = (u16*)take((size_t)NTOK * 256 * 2);
    c.proj = (u16*)take((size_t)NTOK * NMAIN * 2); c.WiT = (u16*)take((size_t)NMAIN * 1024 * 2); c.Hb = (u16*)take((size_t)NTOK * 1024 * 2);
    { const size_t pad = WS_NEED > off && ws_size > WS_NEED ? (WS_NEED - off) & ~(size_t)4095 : 0;
      if (pad) { w += pad; c.bar = (unsigned*)((unsigned char*)c.bar + pad); c.slots = (float*)((unsigned char*)c.slots + pad); c.rs = (float*)((unsigned char*)c.rs + pad); c.gklr = (float*)((unsigned char*)c.gklr + pad);
                 c.dec = (float*)((unsigned char*)c.dec + pad); c.kv = (u16*)((unsigned char*)c.kv + pad); c.WoT = (u16*)((unsigned char*)c.WoT + pad); c.mixed = (u16*)((unsigned char*)c.mixed + pad);
                 c.cs = (u16*)((unsigned char*)c.cs + pad); c.bcum = (u16*)((unsigned char*)c.bcum + pad); c.proj = (u16*)((unsigned char*)c.proj + pad); c.WiT = (u16*)((unsigned char*)c.WiT + pad); c.Hb = (u16*)((unsigned char*)c.Hb + pad); } }
    if (off > WS_NEED || off > ws_size) { fprintf(stderr, "workspace too small: need %zu have %zu\n", off, ws_size); return; }
    if (hipMemsetAsync(c.bar, 0, (size_t)(2 * XCD_BAR_WORDS + 8192) * 4, stream) != hipSuccess) { fprintf(stderr, "memset failed\n"); return; }
    void* args[] = {&c};
    hipError_t e = hipLaunchCooperativeKernel((const void*)hybrid_fwd, dim3(grid_blocks), dim3(512), args, (unsigned)LDS_BYTES, stream);
    if (e != hipSuccess) fprintf(stderr, "cooperative launch failed: %s (grid %d)\n", hipGetErrorString(e), grid_blocks);
}
```
